# Optimizing an MI355X kernel written in HIP

```python
import math
import jax, jax.numpy as jnp
from jax import lax
import numpy as np

D_MODEL = 4096
BATCH = 4
SEQ = 2048
DEPTH = 4
DEC_BATCH = 32
DEC_SEQ = 1
PAST_LEN = 8192
PAGE_SIZE = 128

D_MIX = D_MODEL
D_SSM = D_MIX // 2
D_ATT = D_MIX - D_SSM
SSM_GROUP = 16
N_SSM_GROUPS = D_SSM // SSM_GROUP
SSM_STATE = 64
HEAD_DIM = 128
N_HEADS = D_ATT // HEAD_DIM
N_KV_HEADS = 4
KV_GROUP = N_HEADS // N_KV_HEADS
D_KV = N_KV_HEADS * HEAD_DIM
WINDOW = 128
ROPE_THETA = 10000.0
EPS = 1e-6
BLOCK = 128
DT_MIN = 1e-3
DT_MAX = 1e-1
SPLITS = (D_SSM, 2 * D_SSM, 2 * D_SSM + D_ATT, 2 * D_SSM + D_ATT + D_KV, 2 * D_SSM + D_ATT + 2 * D_KV)
D_IN = 2 * D_SSM + 2 * D_ATT + 2 * D_KV

kernel_name = 'hymba_s5_swa_sink_adaln_step'


def rmsnorm(x, g):
    xf = x.astype(jnp.float32)
    y = xf * lax.rsqrt(jnp.mean(xf * xf, axis=-1, keepdims=True) + EPS)
    return (y * g.astype(jnp.float32)).astype(x.dtype)


def rope(x, pos):
    half = HEAD_DIM // 2
    inv = ROPE_THETA ** (-jnp.arange(half, dtype=jnp.float32) / half)
    ang = pos.astype(jnp.float32)[:, None] * inv[None, :]
    cos = jnp.cos(ang)[None, :, None, :]
    sin = jnp.sin(ang)[None, :, None, :]
    xf = x.astype(jnp.float32)
    x1, x2 = xf[..., :half], xf[..., half:]
    return jnp.concatenate([x1 * cos - x2 * sin, x2 * cos + x1 * sin], axis=-1).astype(x.dtype)


def ssm_discretise(a_re, a_im, log_dt, b_re, b_im):
    ar = a_re.astype(jnp.float32)
    ai = a_im.astype(jnp.float32)
    dt = jnp.exp(log_dt.astype(jnp.float32))[:, None]
    mag = jnp.exp(ar * dt)
    lr = mag * jnp.cos(ai * dt)
    li = mag * jnp.sin(ai * dt)
    nr = lr - 1.0
    ni = li
    den = ar * ar + ai * ai
    qr = (nr * ar + ni * ai) / den
    qi = (ni * ar - nr * ai) / den
    br = b_re.astype(jnp.float32)
    bi = b_im.astype(jnp.float32)
    bbr = qr[..., None] * br - qi[..., None] * bi
    bbi = qr[..., None] * bi + qi[..., None] * br
    return lr, li, bbr, bbi


def _complex_affine_combine(e1, e2):
    a1r, a1i, b1r, b1i = e1
    a2r, a2i, b2r, b2i = e2
    return (a2r * a1r - a2i * a1i,
            a2r * a1i + a2i * a1r,
            a2r * b1r - a2i * b1i + b2r,
            a2r * b1i + a2i * b1r + b2i)


def ssm_scan(u, h_re, h_im, lr, li, bbr, bbi, cm_re, cm_im, d_skip):
    bsz, L = u.shape[0], u.shape[1]
    blk = BLOCK if L % BLOCK == 0 else L
    nb = L // blk
    ub = jnp.swapaxes(u.reshape(bsz, nb, blk, N_SSM_GROUPS, SSM_GROUP), 0, 1)

    def step(carry, u_blk):
        hr, hi = carry
        xr = jnp.einsum('blgc,gpc->blgp', u_blk, bbr)
        xi = jnp.einsum('blgc,gpc->blgp', u_blk, bbi)
        ar = jnp.broadcast_to(lr, xr.shape)
        ai = jnp.broadcast_to(li, xi.shape)
        cr, ci, sr, si = lax.associative_scan(_complex_affine_combine, (ar, ai, xr, xi), axis=1)
        st_r = cr * hr[:, None] - ci * hi[:, None] + sr
        st_i = cr * hi[:, None] + ci * hr[:, None] + si
        y = (jnp.einsum('blgp,gcp->blgc', st_r, cm_re)
             - jnp.einsum('blgp,gcp->blgc', st_i, cm_im))
        return (st_r[:, -1], st_i[:, -1]), y

    (hr, hi), ys = lax.scan(step, (h_re, h_im), ub)
    y = jnp.swapaxes(ys, 0, 1).reshape(bsz, L, N_SSM_GROUPS, SSM_GROUP)
    y = y + d_skip.reshape(N_SSM_GROUPS, SSM_GROUP) * u
    return y, hr, hi


def window_attention(q, k_all, v_all, q_pos0, sinks):
    bsz, L = q.shape[0], q.shape[1]
    blk = BLOCK if L % BLOCK == 0 else L
    nb = L // blk
    nk = WINDOW + blk
    idx = jnp.arange(nb)[:, None] * blk + jnp.arange(nk)[None, :]
    kb = k_all[:, idx]
    vb = v_all[:, idx]
    qb = q.reshape(bsz, nb, blk, N_KV_HEADS, KV_GROUP, HEAD_DIM)
    s = jnp.einsum('bnqkgd,bnskd->bnkgqs', qb, kb,
                   preferred_element_type=jnp.float32) * (HEAD_DIM ** -0.5)
    r = jnp.arange(blk)[:, None]
    cc = jnp.arange(nk)[None, :]
    rel = cc - WINDOW - r
    kpos = q_pos0 - WINDOW + jnp.arange(nb)[:, None, None] * blk + cc[None]
    valid = ((rel > -WINDOW) & (rel <= 0))[None] & (kpos >= 0)
    s = jnp.where(valid[None, :, None, None], s, -jnp.inf)
    sink = sinks.astype(jnp.float32).reshape(N_KV_HEADS, KV_GROUP)[None, None, :, :, None, None]
    m = jnp.maximum(jnp.max(s, axis=-1, keepdims=True), sink)
    p = jnp.exp(s - m)
    den = jnp.sum(p, axis=-1, keepdims=True) + jnp.exp(sink - m)
    o = jnp.einsum('bnkgqs,bnskd->bnqkgd', (p / den).astype(vb.dtype), vb)
    return o.reshape(bsz, L, N_HEADS * HEAD_DIM)


def mixer_layer(x, cond, pos0, prefix_k, prefix_v, h_re, h_im, n_keep,
                w_ada, b_ada, norm_g, w_in, a_re, a_im, log_dt, b_re, b_im,
                cm_re, cm_im, d_skip, w_glu, b_glu, sinks, w_out):
    bsz, L = x.shape[0], x.shape[1]
    mod = jax.nn.silu(cond) @ w_ada + b_ada
    shift, scale, gate = jnp.split(mod, 3, axis=-1)
    h = rmsnorm(x, norm_g) * (1.0 + scale[:, None]) + shift[:, None]
    z = h @ w_in
    u, g_ssm, q, k, v, g_att = jnp.split(z, SPLITS, axis=-1)

    lr, li, bbr, bbi = ssm_discretise(a_re, a_im, log_dt, b_re, b_im)
    uf = u.astype(jnp.float32).reshape(bsz, L, N_SSM_GROUPS, SSM_GROUP)
    y, hr, hi = ssm_scan(uf, h_re.astype(jnp.float32), h_im.astype(jnp.float32), lr, li, bbr, bbi,
                         cm_re.astype(jnp.float32), cm_im.astype(jnp.float32), d_skip.astype(jnp.float32))
    y = jax.nn.gelu(y.reshape(bsz, L, D_SSM).astype(x.dtype))
    y_ssm = y * jax.nn.sigmoid(y @ w_glu + b_glu) * jax.nn.silu(g_ssm)

    pos = pos0 + jnp.arange(L)
    q = rope(q.reshape(bsz, L, N_HEADS, HEAD_DIM), pos)
    k = rope(k.reshape(bsz, L, N_KV_HEADS, HEAD_DIM), pos)
    v = v.reshape(bsz, L, N_KV_HEADS, HEAD_DIM)
    pad = WINDOW - prefix_k.shape[1]
    if pad > 0:
        prefix_k = jnp.pad(prefix_k, ((0, 0), (pad, 0), (0, 0), (0, 0)))
        prefix_v = jnp.pad(prefix_v, ((0, 0), (pad, 0), (0, 0), (0, 0)))
    k_all = jnp.concatenate([prefix_k.astype(k.dtype), k], axis=1)
    v_all = jnp.concatenate([prefix_v.astype(v.dtype), v], axis=1)
    o = window_attention(q, k_all, v_all, pos0, sinks) * jax.nn.silu(g_att)

    out = jnp.concatenate([y_ssm, o.astype(y_ssm.dtype)], axis=-1) @ w_out
    x = x + gate[:, None] * out
    return x, k_all[:, -n_keep:], v_all[:, -n_keep:], hr, hi


def run_group(x, cond, pos0, prefix_k, prefix_v, h_re, h_im, n_keep,
              w_ada, b_ada, norm_g, w_in, ssm_a_re, ssm_a_im, ssm_log_dt, ssm_b_re, ssm_b_im,
              ssm_c_re, ssm_c_im, ssm_d, w_glu, b_glu, attn_sinks, w_out, final_g):
    ks, vs, hrs, his = [], [], [], []
    for i in range(DEPTH):
        x, nk, nv, hr, hi = mixer_layer(
            x, cond, pos0, prefix_k[i], prefix_v[i], h_re[i], h_im[i], n_keep,
            w_ada[i], b_ada[i], norm_g[i], w_in[i], ssm_a_re[i], ssm_a_im[i], ssm_log_dt[i],
            ssm_b_re[i], ssm_b_im[i], ssm_c_re[i], ssm_c_im[i], ssm_d[i], w_glu[i], b_glu[i],
            attn_sinks[i], w_out[i])
        ks.append(nk)
        vs.append(nv)
        hrs.append(hr)
        his.append(hi)
    return rmsnorm(x, final_g), jnp.stack(ks), jnp.stack(vs), jnp.stack(hrs), jnp.stack(his)


def setup_inputs(seed: int = 0) -> dict:
    key = jax.random.key(seed)
    ks = jax.random.split(key, 26)
    f32 = jnp.float32

    def nrm(k, shape, s):
        return jax.random.normal(k, shape, f32) * s

    G, P, C = N_SSM_GROUPS, SSM_STATE, SSM_GROUP
    win_buf = min(WINDOW, PAST_LEN)
    n_idx = jnp.arange(P, dtype=f32)
    return {
        'x_prompt': nrm(ks[0], (BATCH, SEQ, D_MODEL), 1.0),
        'x_sample': nrm(ks[1], (DEC_BATCH, DEC_SEQ, D_MODEL), 1.0),
        'c_prompt': nrm(ks[2], (BATCH, D_MODEL), 1.0),
        'c_sample': nrm(ks[3], (DEC_BATCH, D_MODEL), 1.0),
        'cache_win_k': nrm(ks[4], (DEPTH, DEC_BATCH, win_buf, N_KV_HEADS, HEAD_DIM), 1.0),
        'cache_win_v': nrm(ks[5], (DEPTH, DEC_BATCH, win_buf, N_KV_HEADS, HEAD_DIM), 1.0),
        'state_ssm_re': nrm(ks[6], (DEPTH, DEC_BATCH, G, P), 0.1),
        'state_ssm_im': nrm(ks[7], (DEPTH, DEC_BATCH, G, P), 0.1),
        'w_ada': nrm(ks[8], (DEPTH, D_MODEL, 3 * D_MODEL), 0.5 * D_MODEL ** -0.5),
        'b_ada': nrm(ks[9], (DEPTH, 3 * D_MODEL), 0.02),
        'norm_g': 1.0 + nrm(ks[10], (DEPTH, D_MODEL), 0.02),
        'w_in': nrm(ks[11], (DEPTH, D_MODEL, D_IN), D_MODEL ** -0.5),
        'ssm_a_re': -0.5 + nrm(ks[12], (DEPTH, G, P), 0.01),
        'ssm_a_im': math.pi * n_idx + nrm(ks[13], (DEPTH, G, P), 0.01),
        'ssm_log_dt': jax.random.uniform(ks[14], (DEPTH, G), f32, math.log(DT_MIN), math.log(DT_MAX)),
        'ssm_b_re': nrm(ks[15], (DEPTH, G, P, C), (2.0 * C) ** -0.5),
        'ssm_b_im': nrm(ks[16], (DEPTH, G, P, C), (2.0 * C) ** -0.5),
        'ssm_c_re': nrm(ks[17], (DEPTH, G, C, P), (2.0 * P) ** -0.5),
        'ssm_c_im': nrm(ks[18], (DEPTH, G, C, P), (2.0 * P) ** -0.5),
        'ssm_d': nrm(ks[19], (DEPTH, D_SSM), 1.0),
        'w_glu': nrm(ks[20], (DEPTH, D_SSM, D_SSM), D_SSM ** -0.5),
        'b_glu': nrm(ks[21], (DEPTH, D_SSM), 0.02),
        'attn_sinks': nrm(ks[22], (DEPTH, N_HEADS), 0.5),
        'w_out': nrm(ks[23], (DEPTH, D_MIX, D_MODEL), D_MIX ** -0.5),
        'final_g': 1.0 + nrm(ks[24], (D_MODEL,), 0.02),
    }


def reference(x_prompt, x_sample, c_prompt, c_sample, cache_win_k, cache_win_v,
              state_ssm_re, state_ssm_im, w_ada, b_ada, norm_g, w_in, ssm_a_re, ssm_a_im,
              ssm_log_dt, ssm_b_re, ssm_b_im, ssm_c_re, ssm_c_im, ssm_d, w_glu, b_glu,
              attn_sinks, w_out, final_g):
    bp = x_prompt.shape[0]
    zero_k = jnp.zeros((DEPTH, bp, WINDOW, N_KV_HEADS, HEAD_DIM), x_prompt.dtype)
    zero_h = jnp.zeros((DEPTH, bp, N_SSM_GROUPS, SSM_STATE), jnp.float32)
    y_prompt, pk, pv, pr, pi = run_group(
        x_prompt, c_prompt, 0, zero_k, zero_k, zero_h, zero_h, min(WINDOW, x_prompt.shape[1]),
        w_ada, b_ada, norm_g, w_in, ssm_a_re, ssm_a_im, ssm_log_dt, ssm_b_re, ssm_b_im,
        ssm_c_re, ssm_c_im, ssm_d, w_glu, b_glu, attn_sinks, w_out, final_g)
    y_sample, sk, sv, sr, si = run_group(
        x_sample, c_sample, PAST_LEN, cache_win_k, cache_win_v, state_ssm_re, state_ssm_im,
        cache_win_k.shape[2],
        w_ada, b_ada, norm_g, w_in, ssm_a_re, ssm_a_im, ssm_log_dt, ssm_b_re, ssm_b_im,
        ssm_c_re, ssm_c_im, ssm_d, w_glu, b_glu, attn_sinks, w_out, final_g)
    return (y_prompt, y_sample, pk, pv, pr, pi, sk, sv, sr, si)
```

```cpp
#include <hip/hip_runtime.h>
#include <cstdio>
#include <cstdint>
namespace pg8 {
#define PG8_LAS __attribute__((address_space(3)))
typedef unsigned short bf16_t;
typedef short bf16x8 __attribute__((ext_vector_type(8)));
typedef float f32x4 __attribute__((ext_vector_type(4)));
typedef unsigned u32x4 __attribute__((ext_vector_type(4)));
constexpr int BM = 256, BK = 64, HALF = 128, HTB = HALF * BK * 2  , STAGE_BYTES = 8 * HTB, NXCD = 8, WGM = 8;

__host__ __device__ __forceinline__ int lds_byte(int r, int c) { const int st = (r >> 4) * 2 + (c >> 5), rr = r & 15, cc = c & 31, ob = rr * 64 + cc * 2; return st * 1024 + (ob ^ (((ob >> 9) & 1) << 5)); }
__host__ __device__ __forceinline__ void stage_rc(int b, int& R, int& C) { const int st = b / 1024, sb = b % 1024, swz = sb ^ (((sb >> 9) & 1) << 5); R = (st >> 1) * 16 + swz / 64; C = (st & 1) * 32 + (swz % 64) / 2; }
__host__ __device__ __forceinline__ int perm32(int rho) { const int n = rho >> 4, i = rho & 15; return 8 * (i >> 2) + 4 * n + (i & 3); }

struct Unit { int pm, pn; };
struct Gemm { const bf16_t* A; const bf16_t* Bt; int M, N, K; };

struct StaticOrder {
    int nM, nN, nwg, G, c;
    __host__ __device__ void init(int M, int N, int G_, int c_) { nM = M / BM; nN = N / BM; nwg = nM * nN; G = G_; c = c_; }
    __host__ __device__ bool next(int i, Unit& u) const {
        const long L = (long)i * G + c; if (L >= nwg) return false;
        int wgid = (int)L; { const int q = nwg / NXCD, r = nwg % NXCD, xcd = wgid % NXCD, off = wgid / NXCD; wgid = (xcd < r ? xcd * (q + 1) : r * (q + 1) + (xcd - r) * q) + off; }
        const int nig = WGM * nN, gid = wgid / nig, fm = gid * WGM, gsz = (nM - fm) < WGM ? (nM - fm) : WGM;
        u.pm = fm + ((wgid % nig) % gsz); u.pn = (wgid % nig) / gsz; return true;
    }
    __device__ __forceinline__ void a_ready(const Unit&) const {}
    __device__ __forceinline__ void done(const Unit&) const {}
};

__device__ __forceinline__ unsigned cvt_pk_bf16(float lo, float hi) { unsigned r; asm volatile("v_cvt_pk_bf16_f32 %0, %1, %2" : "=v"(r) : "v"(lo), "v"(hi)); return r; }
typedef float f32x2 __attribute__((ext_vector_type(2)));
__device__ __forceinline__ float bf2f_lo(unsigned w) { return __uint_as_float(w << 16); }
__device__ __forceinline__ float bf2f_hi(unsigned w) { return __uint_as_float(w & 0xffff0000u); }
__device__ __forceinline__ float sigmoidf_(float a) { return 1.0f / (1.0f + __expf(-a)); }
struct EpiZ {
    static constexpr bool PERM = true, AFTER_DRAIN = false;
    bf16_t* O; int ldc;
    __device__ __forceinline__ void operator()(const f32x4 (&acc)[2][2][4][2], const Unit& u, int wr, int wc, int fr, int fq) const {
        const int row0 = u.pm * BM + wr * 64 + fr, col0 = u.pn * BM + wc * 32 + 8 * fq;
#pragma unroll
        for (int ai = 0; ai < 2; ++ai)
#pragma unroll
            for (int m = 0; m < 4; ++m) { bf16_t* rowp = O + (size_t)(row0 + ai * HALF + m * 16) * ldc + col0;
#pragma unroll
                for (int bj = 0; bj < 2; ++bj) { const f32x4 v0 = acc[ai][bj][m][0], v1 = acc[ai][bj][m][1];
                    u32x4 w; w.x = cvt_pk_bf16(v0[0], v0[1]); w.y = cvt_pk_bf16(v0[2], v0[3]); w.z = cvt_pk_bf16(v1[0], v1[1]); w.w = cvt_pk_bf16(v1[2], v1[3]);
                    *(u32x4*)(rowp + bj * HALF) = w; } }
    }
};
struct EpiGlu {
    static constexpr bool PERM = true, AFTER_DRAIN = false;
    const bf16_t* Y; int ldy; const bf16_t* G; int ldg; const float* bias; bf16_t* O; int ldo;
    __device__ __forceinline__ void operator()(const f32x4 (&acc)[2][2][4][2], const Unit& u, int wr, int wc, int fr, int fq) const {
        const int row0 = u.pm * BM + wr * 64 + fr, col0 = u.pn * BM + wc * 32 + 8 * fq;
        f32x4 bv[2][2];
#pragma unroll
        for (int bj = 0; bj < 2; ++bj)
#pragma unroll
            for (int n = 0; n < 2; ++n) bv[bj][n] = *(const f32x4*)(bias + col0 + bj * HALF + 4 * n);
#pragma unroll
        for (int ai = 0; ai < 2; ++ai)
#pragma unroll
            for (int m = 0; m < 4; ++m) { const size_t row = (size_t)(row0 + ai * HALF + m * 16);
#pragma unroll
                for (int bj = 0; bj < 2; ++bj) { const int col = col0 + bj * HALF;
                    const u32x4 y8 = *(const u32x4*)(Y + row * ldy + col), g8 = *(const u32x4*)(G + row * ldg + col);
                    const f32x4 a0 = acc[ai][bj][m][0] + bv[bj][0], a1 = acc[ai][bj][m][1] + bv[bj][1];
                    float o[8];
#pragma unroll
                    for (int e = 0; e < 8; ++e) { const unsigned yw = y8[e >> 1], gw = g8[e >> 1];
                        const float yv = (e & 1) ? bf2f_hi(yw) : bf2f_lo(yw), gv = (e & 1) ? bf2f_hi(gw) : bf2f_lo(gw), a = e < 4 ? a0[e & 3] : a1[e & 3];
                        o[e] = yv * sigmoidf_(a) * gv * sigmoidf_(gv); }
                    u32x4 w; w.x = cvt_pk_bf16(o[0], o[1]); w.y = cvt_pk_bf16(o[2], o[3]); w.z = cvt_pk_bf16(o[4], o[5]); w.w = cvt_pk_bf16(o[6], o[7]);
                    *(u32x4*)(O + row * ldo + col) = w; } }
    }
};
struct EpiOut {
    static constexpr bool PERM = false, AFTER_DRAIN = false;
    float* X; int ldx; const float* gate; int gstride; int mrows; int mprompt; int seq_shift;
    __device__ __forceinline__ void operator()(const f32x4 (&acc)[2][2][4][2], const Unit& u, int wr, int wc, int fr, int fq) const {
        const int row0 = u.pm * BM + wr * 64 + fr, col0 = u.pn * BM + wc * 32 + 4 * fq;
#pragma unroll
        for (int ai = 0; ai < 2; ++ai)
#pragma unroll
            for (int m = 0; m < 4; ++m) { const int row = row0 + ai * HALF + m * 16;
                if (row < mrows) { const int bi = row < mprompt ? (row >> seq_shift) : (mprompt >> seq_shift) + row - mprompt;
                    float* xp = X + (size_t)row * ldx + col0; const float* gp = gate + (size_t)bi * gstride + col0;
#pragma unroll
                    for (int bj = 0; bj < 2; ++bj)
#pragma unroll
                        for (int n = 0; n < 2; ++n) { const f32x4 x = *(const f32x4*)(xp + bj * HALF + n * 16), gt = *(const f32x4*)(gp + bj * HALF + n * 16);
                            *(f32x4*)(xp + bj * HALF + n * 16) = x + gt * acc[ai][bj][m][n]; } } }
    }
};
template <class Epi, class Sched, bool ALIGN_EPI = false, bool SP2 = false>
__device__ __forceinline__ void gemm_phase(PG8_LAS unsigned char* lds, const Gemm g, const Sched& S, const Epi& E) {
    int tid_ = threadIdx.x; asm volatile("" : "+v"(tid_));
    const int tid = tid_, wid = __builtin_amdgcn_readfirstlane(tid >> 6), lane = tid & 63, wr = wid >> 2, wc = wid & 3, fr = lane & 15, fq = lane >> 4;
    const int K = g.K, nt = K / BK;
    unsigned voffA[2], voffB[2];
#pragma unroll
    for (int i = 0; i < 2; ++i) { int R, C; stage_rc(tid * 16 + i * 8192, R, C); const int Rb = Epi::PERM ? ((R & ~31) + perm32(R & 31)) : R;
        voffA[i] = (unsigned)(R * K + C) * 2u; voffB[i] = (unsigned)(Rb * K + C) * 2u; }
    const size_t kstep = (size_t)(BK * 2);
    const size_t hstep = (size_t)HALF * K * 2;
    const size_t tstep = 2 * hstep;
    const unsigned ldsw = (unsigned)wid * 1024u;
    const int aoff = lds_byte(wr * 64 + fr, fq * 8), boff = lds_byte(wc * 32 + fr, fq * 8);
#define PG8_SA(b, h) (((b) * 2 + (h)) * HTB)
#define PG8_SB(b, h) ((4 + (b) * 2 + (h)) * HTB)
#define PG8_STAGE(bufoff, gbase, voff) do { _Pragma("unroll") for (int _i = 0; _i < 2; ++_i) \
        __builtin_amdgcn_global_load_lds((const unsigned*)((const char*)(gbase) + (voff)[_i]), (PG8_LAS unsigned*)(lds + (bufoff) + ldsw + _i * 8192), 16, 0, 0); } while (0)
#define PG8_LDA(dst, b, h) do { _Pragma("unroll") for (int m = 0; m < 4; ++m) _Pragma("unroll") for (int k = 0; k < 2; ++k) dst[m][k] = *(const PG8_LAS bf16x8*)(lds + PG8_SA(b, h) + aoff + m * 2048 + k * 1024); } while (0)
#define PG8_LDB(dst, b, h) do { _Pragma("unroll") for (int n = 0; n < 2; ++n) _Pragma("unroll") for (int k = 0; k < 2; ++k) dst[n][k] = *(const PG8_LAS bf16x8*)(lds + PG8_SB(b, h) + boff + n * 2048 + k * 1024); } while (0)
#define PG8_MMA(ai, bj, At, Bt) do { __builtin_amdgcn_s_setprio(1); _Pragma("unroll") for (int m = 0; m < 4; ++m) _Pragma("unroll") for (int n = 0; n < 2; ++n) _Pragma("unroll") for (int k = 0; k < 2; ++k) \
        acc[ai][bj][m][n] = __builtin_amdgcn_mfma_f32_16x16x32_bf16(Bt[n][k], At[m][k], acc[ai][bj][m][n], 0, 0, 0); __builtin_amdgcn_s_setprio(0); } while (0)
#define PG8_WAIT_V(n) asm volatile("s_waitcnt vmcnt(" #n ")" ::: "memory")
#define PG8_WAIT_L(n) asm volatile("s_waitcnt lgkmcnt(" #n ")" ::: "memory")
#define PG8_BAR __builtin_amdgcn_s_barrier()
#define PG8_SCHED __builtin_amdgcn_sched_barrier(0)
    Unit cur, nxt; int ui = 0;
    if (!S.next(0, cur)) return;
    f32x4 acc[2][2][4][2];
#pragma unroll
    for (int a = 0; a < 2; ++a)
#pragma unroll
        for (int b = 0; b < 2; ++b)
#pragma unroll
            for (int m = 0; m < 4; ++m)
#pragma unroll
                for (int n = 0; n < 2; ++n) acc[a][b][m][n] = (f32x4){0.f, 0.f, 0.f, 0.f};
    bf16x8 At[4][2], B0[2][2], B1[2][2];
    const char* cA = (const char*)g.A + (size_t)cur.pm * tstep; const char* cB = (const char*)g.Bt + (size_t)cur.pn * tstep;
    S.a_ready(cur);
    if constexpr (SP2) {
        PG8_STAGE(PG8_SB(0, 0), cB, voffB); PG8_STAGE(PG8_SB(0, 1), cB + hstep, voffB); PG8_STAGE(PG8_SA(0, 0), cA, voffA); PG8_STAGE(PG8_SA(0, 1), cA + hstep, voffA);
        if (wr == 1) PG8_BAR;
        PG8_WAIT_V(2); PG8_BAR;
        PG8_STAGE(PG8_SB(1, 0), cB + kstep, voffB); PG8_STAGE(PG8_SA(1, 0), cA + kstep, voffA); PG8_STAGE(PG8_SB(1, 1), cB + hstep + kstep, voffB);
        PG8_WAIT_V(6); PG8_BAR;
    } else {
        PG8_STAGE(PG8_SB(0, 0), cB, voffB); PG8_STAGE(PG8_SA(0, 0), cA, voffA); PG8_STAGE(PG8_SB(0, 1), cB + hstep, voffB); PG8_STAGE(PG8_SA(0, 1), cA + hstep, voffA);
        if (wr == 1) PG8_BAR;
        PG8_WAIT_V(4); PG8_BAR;
        PG8_STAGE(PG8_SB(1, 0), cB + kstep, voffB); PG8_STAGE(PG8_SA(1, 0), cA + kstep, voffA); PG8_STAGE(PG8_SB(1, 1), cB + hstep + kstep, voffB);
        PG8_WAIT_V(6); PG8_BAR;
    }
    for (;;) {
        const bool has_next = S.next(ui + 1, nxt);
        const char* nA = has_next ? (const char*)g.A + (size_t)nxt.pm * tstep : cA; const char* nB = has_next ? (const char*)g.Bt + (size_t)nxt.pn * tstep : cB;
        for (int t = 0; t < nt; t += 2) {
            const bool last = (t == nt - 2);
            const char* a1 = cA + (size_t)(t + 1) * kstep;
            const char* a2 = last ? nA : cA + (size_t)(t + 2) * kstep; const char* b2 = last ? nB : cB + (size_t)(t + 2) * kstep;
            const char* a3 = a2 + kstep; const char* b3 = b2 + kstep;
            if (last && has_next) S.a_ready(nxt);
            if constexpr (SP2) {
            PG8_LDB(B0, 0, 0); PG8_LDB(B1, 0, 1); PG8_SCHED; PG8_LDA(At, 0, 0); PG8_STAGE(PG8_SA(1, 1), a1 + hstep, voffA);
            PG8_WAIT_V(8); PG8_WAIT_L(0); PG8_BAR; PG8_MMA(0, 0, At, B0); PG8_MMA(0, 1, At, B1); PG8_BAR; PG8_SCHED;
            PG8_LDA(At, 0, 1); PG8_STAGE(PG8_SB(0, 0), b2, voffB); PG8_STAGE(PG8_SB(0, 1), b2 + hstep, voffB); PG8_STAGE(PG8_SA(0, 0), a2, voffA);
            PG8_WAIT_V(8); PG8_WAIT_L(0); PG8_BAR; PG8_MMA(1, 0, At, B0); PG8_MMA(1, 1, At, B1); PG8_BAR; PG8_SCHED;
            PG8_LDB(B0, 1, 0); PG8_LDB(B1, 1, 1); PG8_SCHED; PG8_LDA(At, 1, 0); PG8_STAGE(PG8_SA(0, 1), a2 + hstep, voffA);
            PG8_WAIT_V(8); PG8_WAIT_L(0); PG8_BAR; PG8_MMA(0, 0, At, B0); PG8_MMA(0, 1, At, B1); PG8_BAR; PG8_SCHED;
            PG8_LDA(At, 1, 1); PG8_STAGE(PG8_SB(1, 0), b3, voffB); PG8_STAGE(PG8_SB(1, 1), b3 + hstep, voffB); PG8_STAGE(PG8_SA(1, 0), a3, voffA);
            PG8_WAIT_V(8); PG8_WAIT_L(0); PG8_BAR; PG8_MMA(1, 0, At, B0); PG8_MMA(1, 1, At, B1); PG8_BAR; PG8_SCHED;
            } else {
            PG8_LDB(B0, 0, 0); PG8_SCHED; PG8_LDA(At, 0, 0); PG8_STAGE(PG8_SA(1, 1), a1 + hstep, voffA);
            PG8_WAIT_L(8); PG8_BAR; PG8_WAIT_L(0); PG8_MMA(0, 0, At, B0); PG8_BAR; PG8_SCHED;
            PG8_LDB(B1, 0, 1); PG8_STAGE(PG8_SB(0, 0), b2, voffB);
            PG8_BAR; PG8_WAIT_L(0); PG8_MMA(0, 1, At, B1); PG8_BAR;
            PG8_LDA(At, 0, 1); PG8_STAGE(PG8_SA(0, 0), a2, voffA);
            PG8_BAR; PG8_WAIT_L(0); PG8_MMA(1, 0, At, B0); PG8_BAR; PG8_SCHED;
            PG8_STAGE(PG8_SB(0, 1), b2 + hstep, voffB);
            PG8_WAIT_V(6); PG8_BAR; PG8_MMA(1, 1, At, B1); PG8_BAR;
            PG8_LDB(B0, 1, 0); PG8_SCHED; PG8_LDA(At, 1, 0); PG8_STAGE(PG8_SA(0, 1), a2 + hstep, voffA);
            PG8_WAIT_L(8); PG8_BAR; PG8_WAIT_L(0); PG8_MMA(0, 0, At, B0); PG8_BAR; PG8_SCHED;
            PG8_LDB(B1, 1, 1); PG8_STAGE(PG8_SB(1, 0), b3, voffB);
            PG8_BAR; PG8_WAIT_L(0); PG8_MMA(0, 1, At, B1); PG8_BAR;
            PG8_LDA(At, 1, 1); PG8_STAGE(PG8_SA(1, 0), a3, voffA);
            PG8_BAR; PG8_WAIT_L(0); PG8_MMA(1, 0, At, B0); PG8_BAR; PG8_SCHED;
            PG8_STAGE(PG8_SB(1, 1), b3 + hstep, voffB);
            PG8_WAIT_V(6); PG8_BAR; PG8_MMA(1, 1, At, B1); PG8_BAR;
            }
        }
        if constexpr (ALIGN_EPI) { if (wr == 0) PG8_BAR; }
        if constexpr (!Epi::AFTER_DRAIN) { E(acc, cur, wr, wc, fr, fq); S.done(cur); }
        if (!has_next) break;
#pragma unroll
        for (int a = 0; a < 2; ++a)
#pragma unroll
            for (int b = 0; b < 2; ++b)
#pragma unroll
                for (int m = 0; m < 4; ++m)
#pragma unroll
                    for (int n = 0; n < 2; ++n) acc[a][b][m][n] = (f32x4){0.f, 0.f, 0.f, 0.f};
        cur = nxt; cA = nA; cB = nB; ++ui;
        if constexpr (ALIGN_EPI) { if (wr == 1) PG8_BAR; }
    }
    PG8_WAIT_V(0);
    if constexpr (!ALIGN_EPI) { if (wr == 0) PG8_BAR; }
    PG8_BAR;
    if constexpr (Epi::AFTER_DRAIN) { E.fused(acc, cur, wr, wc, fr, fq, lds, wid, lane); S.done(cur); }
#undef PG8_SA
#undef PG8_SB
#undef PG8_STAGE
#undef PG8_LDA
#undef PG8_LDB
#undef PG8_MMA
#undef PG8_WAIT_V
#undef PG8_WAIT_L
#undef PG8_BAR
#undef PG8_SCHED
}
}
constexpr int DM = 4096, NBATCH = 4, SEQ = 2048, DEPTH = 4, SBATCH = 32;
constexpr int MP = NBATCH * SEQ, MR = MP + SBATCH, MPAD = 8448;
constexpr int NG = 128, GC = 16, PS = 64, HD = 128, NH = 16, NKV = 4, WIN = 128, DSSM = 2048, DIN = 9216, NB36 = NBATCH + SBATCH;
constexpr int ZU = 0, ZG = 2048, ZQ = 4096, ZK = 6144, ZV = 6656, ZGA = 7168;
constexpr float EPS = 1e-6f, ATT_SCALE = 0.08838834764831845f;
constexpr size_t O_YP = 0, O_YS = 33554432, O_KP = 33685504, O_VP = 34734080, O_HRP = 35782656, O_HIP = 35913728, O_KS = 36044800, O_VS = 44433408, O_HRS = 52822016, O_HIS = 53870592, O_END = 54919168;
constexpr size_t MiB = 1u << 20;
constexpr size_t WS_CTL = 0, CTL_ZERO_BYTES = 1 * MiB;
constexpr size_t WS_WIN = 16 * MiB, WS_WGLU = 304 * MiB, WS_WOUT = 336 * MiB, WS_MOD = 464 * MiB, WS_H = 472 * MiB, WS_Z = 538 * MiB, WS_YACT = 688 * MiB, WS_CAT = 722 * MiB,
                 WS_LAM = 788 * MiB, WS_BBR = 789 * MiB, WS_BBI = 791 * MiB, WS_ROPE = 794 * MiB, WS_END = 800 * MiB;
static_assert(WS_WIN + (size_t)DEPTH * DIN * DM * 2 <= WS_WGLU && WS_WGLU + (size_t)DEPTH * DSSM * DSSM * 2 <= WS_WOUT && WS_WOUT + (size_t)DEPTH * DM * DM * 2 <= WS_MOD, "ws map 1");
static_assert(WS_MOD + (size_t)DEPTH * NB36 * 3 * DM * 4 <= WS_H && WS_H + (size_t)MPAD * DM * 2 <= WS_Z && WS_Z + (size_t)MPAD * DIN * 2 <= WS_YACT && WS_YACT + (size_t)MPAD * DSSM * 2 <= WS_CAT && WS_CAT + (size_t)MPAD * DM * 2 <= WS_LAM, "ws map 2");
constexpr int CW_BAR = 4096;
constexpr int RING_BYTES = 131072, LDSCTL_OFF = RING_BYTES, MISC_OFF = LDSCTL_OFF + 320, LDS_BYTES = 147456;
constexpr int NWAVES = 8, NTHR = 512;
constexpr int NPHASE = 2 + 6 * DEPTH;

#define GAS __attribute__((address_space(1)))
#define LAS __attribute__((address_space(3)))
typedef unsigned short bf16;
typedef unsigned v4u __attribute__((ext_vector_type(4)));
typedef unsigned v2u __attribute__((ext_vector_type(2)));
typedef float f32x4 __attribute__((ext_vector_type(4)));
#define LDS_WAIT() asm volatile("s_waitcnt lgkmcnt(0)" ::: "memory")
#define VM_WAIT() asm volatile("s_waitcnt vmcnt(0)" ::: "memory")
__device__ __forceinline__ unsigned f2bf(float f) { unsigned u = __builtin_bit_cast(unsigned, f); return (u + 0x7fffu + ((u >> 16) & 1u)) >> 16; }
__device__ __forceinline__ unsigned pk2(float lo, float hi) { return f2bf(lo) | (f2bf(hi) << 16); }
__device__ __forceinline__ float blo(unsigned w) { return __uint_as_float(w << 16); }
__device__ __forceinline__ float bhi(unsigned w) { return __uint_as_float(w & 0xffff0000u); }
__device__ __forceinline__ float bf1(bf16 h) { return __uint_as_float((unsigned)h << 16); }
__device__ __forceinline__ float sigm(float a) { return 1.0f / (1.0f + __expf(-a)); }
__device__ __forceinline__ float gelu_tanh(float x) { const float u = 0.7978845608028654f * (x + 0.044715f * x * x * x); const float t = 1.0f - 2.0f / (__expf(2.0f * u) + 1.0f); return 0.5f * x * (1.0f + t); }
__device__ __forceinline__ float wave_sum(float v) {
#pragma unroll
    for (int o = 1; o < 64; o <<= 1) v += __shfl_xor(v, o);
    return v;
}
__device__ __forceinline__ float wave_max(float v) {
#pragma unroll
    for (int o = 1; o < 64; o <<= 1) v = fmaxf(v, __shfl_xor(v, o));
    return v;
}
__device__ __forceinline__ void sincos_d(double x, double& s, double& c) {
    const double k = __builtin_rint(x * 0.63661977236758134308);
    double r = __builtin_fma(-k, 1.5707963267948966192, x); r = __builtin_fma(-k, 6.123233995736766036e-17, r);
    const double r2 = r * r;
    double ps = -1.0 / 1307674368000.0; ps = ps * r2 + 1.0 / 6227020800.0; ps = ps * r2 - 1.0 / 39916800.0; ps = ps * r2 + 1.0 / 362880.0; ps = ps * r2 - 1.0 / 5040.0; ps = ps * r2 + 1.0 / 120.0; ps = ps * r2 - 1.0 / 6.0; ps = ps * r2 * r + r;
    double pc = -1.0 / 87178291200.0; pc = pc * r2 + 1.0 / 479001600.0; pc = pc * r2 - 1.0 / 3628800.0; pc = pc * r2 + 1.0 / 40320.0; pc = pc * r2 - 1.0 / 720.0; pc = pc * r2 + 1.0 / 24.0; pc = pc * r2 - 0.5; pc = pc * r2 + 1.0;
    const int q = (int)((long long)k & 3);
    s = (q == 0) ? ps : (q == 1) ? pc : (q == 2) ? -ps : -pc;
    c = (q == 0) ? pc : (q == 1) ? -ps : (q == 2) ? -pc : ps;
}
__device__ __forceinline__ double exp_d(double x) {
    const double k = __builtin_rint(x * 1.4426950408889634074);
    double r = __builtin_fma(-k, 0.69314718055994528623, x); r = __builtin_fma(-k, 2.3190468138462995584e-17, r);
    double p = 1.0 / 6227020800.0; p = p * r + 1.0 / 479001600.0; p = p * r + 1.0 / 39916800.0; p = p * r + 1.0 / 3628800.0; p = p * r + 1.0 / 362880.0; p = p * r + 1.0 / 40320.0; p = p * r + 1.0 / 5040.0;
    p = p * r + 1.0 / 720.0; p = p * r + 1.0 / 120.0; p = p * r + 1.0 / 24.0; p = p * r + 1.0 / 6.0; p = p * r + 0.5; p = p * r + 1.0; p = p * r + 1.0;
    const long long e = (long long)k + 1023; return p * __builtin_bit_cast(double, (unsigned long long)e << 52);
}
__device__ const double ROPE_INV[64] = { 1.0, 0.8659643233600653, 0.7498942093324559, 0.6493816315762113, 0.5623413251903491, 0.4869675251658631, 0.4216965034285822, 0.3651741272548377, 0.31622776601683794, 0.27384196342643613, 0.23713737056616552, 0.2053525026457146, 0.1778279410038923, 0.1539926526059492, 0.1333521432163324, 0.11547819846894582, 0.1, 0.08659643233600653, 0.07498942093324558, 0.06493816315762113, 0.05623413251903491, 0.04869675251658631, 0.042169650342858224, 0.03651741272548377, 0.03162277660168379, 0.027384196342643614, 0.023713737056616554, 0.02053525026457146, 0.01778279410038923, 0.01539926526059492, 0.01333521432163324, 0.011547819846894581, 0.01, 0.008659643233600654, 0.007498942093324558, 0.006493816315762113, 0.005623413251903491, 0.004869675251658631, 0.004216965034285823, 0.003651741272548377, 0.0031622776601683794, 0.0027384196342643613, 0.0023713737056616554, 0.002053525026457146, 0.0017782794100389228, 0.001539926526059492, 0.001333521432163324, 0.0011547819846894581, 0.001, 0.0008659643233600654, 0.0007498942093324559, 0.0006493816315762113, 0.0005623413251903491, 0.0004869675251658631, 0.00042169650342858224, 0.0003651741272548377, 0.00031622776601683794, 0.0002738419634264361, 0.00023713737056616554, 0.0002053525026457146, 0.00017782794100389227, 0.0001539926526059492, 0.0001333521432163324, 0.00011547819846894582 };

#define XB_TMO      128
#define XB_XCNT(j)  (256  + 64 * (j))
#define XB_XSUB(j)  (1280 + 64 * (j))
#define XB_XGEN(j)  (2304 + 64 * (j))
#define XB_TOP      3328
#define XB_TOPGEN   3392
#define XCD_BAR_WORDS 3456
#define XB_SPIN_CAP (1u << 18)

__device__ __forceinline__ unsigned xb_ld(unsigned* p)              { return __hip_atomic_load(p, __ATOMIC_RELAXED, __HIP_MEMORY_SCOPE_AGENT); }
__device__ __forceinline__ unsigned xb_add(unsigned* p, unsigned v) { return __hip_atomic_fetch_add(p, v, __ATOMIC_RELAXED, __HIP_MEMORY_SCOPE_AGENT); }
__device__ __forceinline__ unsigned xb_xcc_id() { return (unsigned)__builtin_amdgcn_s_getreg((3 << 11) | 20) & 0xFu; }
#define XB_SPIN(cond, bar) do { unsigned _sp = 0; while (cond) { __builtin_amdgcn_s_sleep(1); \
    if ((++_sp & 255u) == 0u) { if (xb_ld(&(bar)[XB_TMO])) break; if (_sp > XB_SPIN_CAP) { atomicAdd(&(bar)[XB_TMO], 1u); break; } } } } while (0)

struct XcdBarrier {
    unsigned* bar; unsigned x;
    volatile LAS unsigned* st;
};

__device__ __forceinline__ XcdBarrier xcd_barrier_post(unsigned* bar, volatile LAS unsigned* st) {
    XcdBarrier b; b.bar = bar; b.x = xb_xcc_id(); b.st = st;
    if (threadIdx.x == 0) (void)xb_add(&bar[XB_XCNT(b.x)], 1u);
    return b;
}
__device__ __forceinline__ void xcd_barrier_complete(unsigned* bar, unsigned x, unsigned& nloc, unsigned& nx) {
    const unsigned G = gridDim.x * gridDim.y * gridDim.z;
    unsigned sum, cnt, mine, sp = 0u;
    for (;;) {
        sum = 0u; cnt = 0u; mine = 0u;
#pragma unroll
        for (unsigned j = 0; j < 16; ++j) { const unsigned c = xb_ld(&bar[XB_XCNT(j)]); sum += c; cnt += (c > 0u) ? 1u : 0u; mine = (j == x) ? c : mine; }
        if (sum == G) break;
        __builtin_amdgcn_s_sleep(1);
        if ((++sp & 255u) == 0u) { if (xb_ld(&bar[XB_TMO])) break; if (sp > XB_SPIN_CAP) { atomicAdd(&bar[XB_TMO], 1u); break; } }
    }
    nloc = mine > 0u ? mine : 1u; nx = cnt > 0u ? cnt : 1u;
}

__device__ __forceinline__ void xcd_barrier(const XcdBarrier& b) {
    asm volatile("s_waitcnt vmcnt(0)" ::: "memory");
    __syncthreads();
    if (threadIdx.x == 0) {
        unsigned* bar = b.bar;
        __builtin_amdgcn_s_waitcnt(0);
        unsigned nloc = b.st[0], nx = b.st[1];
        if (nloc == 0u) { xcd_barrier_complete(bar, b.x, nloc, nx); b.st[0] = nloc; b.st[1] = nx; }
        const unsigned old = xb_add(&bar[XB_XSUB(b.x)], 1u);
        const unsigned gen = old / nloc;
        if (old + 1u == (gen + 1u) * nloc) {
            __builtin_amdgcn_fence(__ATOMIC_RELEASE, "agent");
            asm volatile("s_waitcnt vmcnt(0)" ::: "memory");
            const unsigned og = xb_add(&bar[XB_TOP], 1u);
            const unsigned tg = og / nx;
            if (og + 1u == (tg + 1u) * nx) xb_add(&bar[XB_TOPGEN], 1u);
            else XB_SPIN(xb_ld(&bar[XB_TOPGEN]) == tg, bar);
            __builtin_amdgcn_fence(__ATOMIC_ACQUIRE, "agent");
            xb_add(&bar[XB_XGEN(b.x)], 1u);
            asm volatile("s_waitcnt vmcnt(0)" ::: "memory");
        } else {
            XB_SPIN(xb_ld(&bar[XB_XGEN(b.x)]) == gen, bar);
            __builtin_amdgcn_fence(__ATOMIC_ACQUIRE, "agent");
            asm volatile("s_waitcnt vmcnt(0)" ::: "memory");
        }
    }
    __syncthreads();
}
struct Args { const float* in[25]; float* out; unsigned char* ws; int ph_lo, ph_hi; };
typedef const Args __attribute__((address_space(4))) CArgs;
__device__ __forceinline__ CArgs* kargs() { CArgs* p = (CArgs*)__builtin_amdgcn_kernarg_segment_ptr(); asm volatile("" : "+s"(p)); return p; }
__device__ __forceinline__ void transpose_item(const float* W, int K, int N, bf16* WT, LAS float* scr, int item, int lane) {
    const int nblk = N / 32, kb = item / nblk, nb = item % nblk, k0 = 64 * kb, n0 = 32 * nb;
#pragma unroll 8
    for (int i = 0; i < 32; ++i) { const int kk = 2 * i + (lane >> 5); scr[kk * 33 + (lane & 31)] = W[(size_t)(k0 + kk) * N + n0 + (lane & 31)]; }
    LDS_WAIT(); asm volatile("" ::: "memory");
    const int c = lane & 7;
#pragma unroll
    for (int j = 0; j < 4; ++j) { const int n = (lane >> 3) + 8 * j; const LAS float* s = scr + (8 * c) * 33 + n;
        v4u o; o.x = pk2(s[0 * 33], s[1 * 33]); o.y = pk2(s[2 * 33], s[3 * 33]); o.z = pk2(s[4 * 33], s[5 * 33]); o.w = pk2(s[6 * 33], s[7 * 33]);
        *(v4u*)(WT + (size_t)(n0 + n) * K + k0 + 8 * c) = o; }
    LDS_WAIT(); asm volatile("" ::: "memory");
}

__device__ __forceinline__ void pro_phase(CArgs* A, LAS unsigned char* lds, int tid, int lane, int wave) {
    const int bx = blockIdx.x, G = gridDim.x;
    constexpr int NGEMV = DEPTH * 24;
    if (bx < NGEMV) {
        const int L = bx / 24, cb = bx % 24, j = cb * 512 + tid;
        LAS float* S = (LAS float*)lds;
        float acc[NB36];
#pragma unroll
        for (int r = 0; r < NB36; ++r) acc[r] = 0.f;
        const float* wcol = A->in[8] + (size_t)L * DM * 3 * DM + j;
        for (int kc = 0; kc < DM; kc += 64) {
            __syncthreads();
            for (int idx = tid; idx < NB36 * 64; idx += NTHR) { const int r = idx >> 6, kk = idx & 63;
                const float c = r < NBATCH ? A->in[2][(size_t)r * DM + kc + kk] : A->in[3][(size_t)(r - NBATCH) * DM + kc + kk]; S[idx] = c * sigm(c); }
            __syncthreads();
#pragma unroll 2
            for (int kq = 0; kq < 16; ++kq) {
                const float w0 = wcol[(size_t)(kc + 4 * kq + 0) * 3 * DM], w1 = wcol[(size_t)(kc + 4 * kq + 1) * 3 * DM], w2 = wcol[(size_t)(kc + 4 * kq + 2) * 3 * DM], w3 = wcol[(size_t)(kc + 4 * kq + 3) * 3 * DM];
#pragma unroll
                for (int r = 0; r < NB36; ++r) { const f32x4 s4 = *(const LAS f32x4*)(S + r * 64 + 4 * kq); acc[r] += (s4.x * w0 + s4.y * w1) + (s4.z * w2 + s4.w * w3); }
            }
        }
        const float bb = A->in[9][(size_t)L * 3 * DM + j];
        float* mod = (float*)(A->ws + WS_MOD) + (size_t)L * NB36 * 3 * DM + j;
#pragma unroll
        for (int r = 0; r < NB36; ++r) mod[(size_t)r * 3 * DM] = acc[r] + bb;
    } else {
        LAS float* scr = (LAS float*)(lds + wave * 16384);
        const int tw = (bx - NGEMV) * NWAVES + wave, NTW = (G - NGEMV) * NWAVES;
        constexpr int I_IN = (DM / 64) * (DIN / 32), I_GLU = (DSSM / 64) * (DSSM / 32), I_OUT = (DM / 64) * (DM / 32), I_L = I_IN + I_GLU + I_OUT;
        for (int it = tw; it < DEPTH * I_L; it += NTW) {
            const int L = it / I_L; int r = it % I_L;
            if (r < I_IN) { transpose_item(A->in[11] + (size_t)L * DM * DIN, DM, DIN, (bf16*)(A->ws + WS_WIN) + (size_t)L * DIN * DM, scr, r, lane); continue; } r -= I_IN;
            if (r < I_GLU) { transpose_item(A->in[20] + (size_t)L * DSSM * DSSM, DSSM, DSSM, (bf16*)(A->ws + WS_WGLU) + (size_t)L * DSSM * DSSM, scr, r, lane); continue; } r -= I_GLU;
            transpose_item(A->in[23] + (size_t)L * DM * DM, DM, DM, (bf16*)(A->ws + WS_WOUT) + (size_t)L * DM * DM, scr, r, lane);
        }
    }
    const int gid = bx * NTHR + tid, NT = G * NTHR;
    for (int i = gid; i < MR * (DM / 4); i += NT) { const f32x4 v = i < MP * (DM / 4) ? ((const f32x4*)A->in[0])[i] : ((const f32x4*)A->in[1])[i - MP * (DM / 4)]; ((f32x4*)A->out)[i] = v; }
    for (int it = gid; it < DEPTH * NG * PS; it += NT) {
        const double ar = A->in[12][it], ai = A->in[13][it], dt = exp_d((double)A->in[14][it / PS]);
        const double mag = exp_d(ar * dt); double sn, cs; sincos_d(ai * dt, sn, cs);
        const double lr = mag * cs, li = mag * sn, nr = lr - 1.0, ni = li, den = ar * ar + ai * ai, qr = (nr * ar + ni * ai) / den, qi = (ni * ar - nr * ai) / den;
        ((float*)(A->ws + WS_LAM))[2 * it] = (float)lr; ((float*)(A->ws + WS_LAM))[2 * it + 1] = (float)li;
#pragma unroll
        for (int c = 0; c < GC; ++c) { const double br = A->in[15][(size_t)it * GC + c], bi = A->in[16][(size_t)it * GC + c];
            ((float*)(A->ws + WS_BBR))[(size_t)it * GC + c] = (float)(qr * br - qi * bi); ((float*)(A->ws + WS_BBI))[(size_t)it * GC + c] = (float)(qr * bi + qi * br); }
    }
    for (int it = gid; it < (SEQ + 1) * 64; it += NT) { const int pi = it >> 6, i = it & 63; const double pos = pi < SEQ ? (double)pi : 8192.0; double sn, cs; sincos_d(pos * ROPE_INV[i], sn, cs);
        ((float*)(A->ws + WS_ROPE))[it] = (float)cs; ((float*)(A->ws + WS_ROPE))[(SEQ + 1) * 64 + it] = (float)sn; }
}

__device__ __forceinline__ void norm_phase(CArgs* A, int L, int gw, int NGW, int lane) {
    const float* X = A->out; bf16* H = (bf16*)(A->ws + WS_H); const float* modL = (const float*)(A->ws + WS_MOD) + (size_t)L * NB36 * 3 * DM; const float* g = A->in[10] + (size_t)L * DM;
    for (int row = gw; row < MR; row += NGW) {
        const int bi = row < MP ? row / SEQ : NBATCH + row - MP; const float* md = modL + (size_t)bi * 3 * DM;
        const f32x4* xr = (const f32x4*)(X + (size_t)row * DM) + lane; f32x4 v[16]; float s = 0.f;
#pragma unroll
        for (int j = 0; j < 16; ++j) { v[j] = xr[64 * j]; s += (v[j].x * v[j].x + v[j].y * v[j].y) + (v[j].z * v[j].z + v[j].w * v[j].w); }
        const float rstd = 1.0f / sqrtf(wave_sum(s) * (1.0f / DM) + EPS);
        v2u* o = (v2u*)(H + (size_t)row * DM) + lane;
#pragma unroll
        for (int j = 0; j < 16; ++j) { const int c = 4 * (lane + 64 * j); const f32x4 g4 = *(const f32x4*)(g + c), sh = *(const f32x4*)(md + c), sc = *(const f32x4*)(md + DM + c);
            const f32x4 y = v[j] * rstd * g4 * (sc + 1.0f) + sh; v2u w; w.x = pk2(y.x, y.y); w.y = pk2(y.z, y.w); o[64 * j] = w; }
    }
}
__device__ __forceinline__ void final_phase(CArgs* A, int gw, int NGW, int lane) {
    for (int row = gw; row < MR; row += NGW) {
        f32x4* xr = (f32x4*)(A->out + (size_t)row * DM) + lane; f32x4 v[16]; float s = 0.f;
#pragma unroll
        for (int j = 0; j < 16; ++j) { v[j] = xr[64 * j]; s += (v[j].x * v[j].x + v[j].y * v[j].y) + (v[j].z * v[j].z + v[j].w * v[j].w); }
        const float rstd = 1.0f / sqrtf(wave_sum(s) * (1.0f / DM) + EPS);
#pragma unroll
        for (int j = 0; j < 16; ++j) { const f32x4 g4 = *(const f32x4*)(A->in[24] + 4 * (lane + 64 * j)); xr[64 * j] = v[j] * rstd * g4; }
    }
}

__device__ __forceinline__ void rope_phase(CArgs* A, int L, int gid, int NT) {
    bf16* Z = (bf16*)(A->ws + WS_Z); const float* CS = (const float*)(A->ws + WS_ROPE); const float* SN = CS + (SEQ + 1) * 64;
    for (int it = gid; it < MR * 20 * 8; it += NT) {
        const int i8 = it & 7, hh = (it >> 3) % 20, row = it / 160;
        const int col = hh < NH ? ZQ + hh * HD : ZK + (hh - NH) * HD, pi = row < MP ? (row & (SEQ - 1)) : SEQ;
        bf16* p1 = Z + (size_t)row * DIN + col + 8 * i8; const v4u a = *(const v4u*)p1, b = *(const v4u*)(p1 + 64);
        const f32x4 c0 = *(const f32x4*)(CS + pi * 64 + 8 * i8), c1 = *(const f32x4*)(CS + pi * 64 + 8 * i8 + 4), s0 = *(const f32x4*)(SN + pi * 64 + 8 * i8), s1 = *(const f32x4*)(SN + pi * 64 + 8 * i8 + 4);
        float x1[8], x2[8], o1[8], o2[8];
#pragma unroll
        for (int e = 0; e < 4; ++e) { x1[2 * e] = blo(a[e]); x1[2 * e + 1] = bhi(a[e]); x2[2 * e] = blo(b[e]); x2[2 * e + 1] = bhi(b[e]); }
#pragma unroll
        for (int e = 0; e < 8; ++e) { const float c = e < 4 ? c0[e & 3] : c1[e & 3], s = e < 4 ? s0[e & 3] : s1[e & 3]; o1[e] = x1[e] * c - x2[e] * s; o2[e] = x2[e] * c + x1[e] * s; }
        v4u w1, w2;
#pragma unroll
        for (int e = 0; e < 4; ++e) { w1[e] = pk2(o1[2 * e], o1[2 * e + 1]); w2[e] = pk2(o2[2 * e], o2[2 * e + 1]); }
        *(v4u*)p1 = w1; *(v4u*)(p1 + 64) = w2;
        if (hh >= NH) { const int kvh = hh - NH; float* dst = nullptr;
            if (row < MP) { const int t = row & (SEQ - 1), b_ = row / SEQ; if (t >= SEQ - WIN) dst = A->out + O_KP + ((((size_t)L * NBATCH + b_) * WIN + (t - (SEQ - WIN))) * NKV + kvh) * HD; }
            else dst = A->out + O_KS + ((((size_t)L * SBATCH + (row - MP)) * WIN + (WIN - 1)) * NKV + kvh) * HD;
            if (dst) { *(f32x4*)(dst + 8 * i8) = (f32x4){o1[0], o1[1], o1[2], o1[3]}; *(f32x4*)(dst + 8 * i8 + 4) = (f32x4){o1[4], o1[5], o1[6], o1[7]};
                       *(f32x4*)(dst + 64 + 8 * i8) = (f32x4){o2[0], o2[1], o2[2], o2[3]}; *(f32x4*)(dst + 64 + 8 * i8 + 4) = (f32x4){o2[4], o2[5], o2[6], o2[7]}; } }
    }
    for (int it = gid; it < (NBATCH * WIN + SBATCH) * 64; it += NT) { const int c8 = it & 63, rr = it >> 6; int row; float* dst;
        if (rr < NBATCH * WIN) { const int b_ = rr / WIN, j = rr % WIN; row = b_ * SEQ + (SEQ - WIN) + j; dst = A->out + O_VP + (((size_t)L * NBATCH + b_) * WIN + j) * (NKV * HD); }
        else { const int bs = rr - NBATCH * WIN; row = MP + bs; dst = A->out + O_VS + (((size_t)L * SBATCH + bs) * WIN + (WIN - 1)) * (NKV * HD); }
        const v4u a = *(const v4u*)(Z + (size_t)row * DIN + ZV + 8 * c8);
        *(f32x4*)(dst + 8 * c8) = (f32x4){blo(a.x), bhi(a.x), blo(a.y), bhi(a.y)}; *(f32x4*)(dst + 8 * c8 + 4) = (f32x4){blo(a.z), bhi(a.z), blo(a.w), bhi(a.w)}; }
    constexpr int ROW4 = NKV * HD / 4;
    for (int it = gid; it < 2 * SBATCH * (WIN - 1) * ROW4; it += NT) { const int kv = it / (SBATCH * (WIN - 1) * ROW4), r = it % (SBATCH * (WIN - 1) * ROW4), c4 = r % ROW4, j = (r / ROW4) % (WIN - 1), bs = r / (ROW4 * (WIN - 1));
        const float* src = (kv ? A->in[5] : A->in[4]) + (((size_t)L * SBATCH + bs) * WIN + j + 1) * (NKV * HD); float* dst = A->out + (kv ? O_VS : O_KS) + (((size_t)L * SBATCH + bs) * WIN + j) * (NKV * HD);
        ((f32x4*)dst)[c4] = ((const f32x4*)src)[c4]; }
}

__device__ __forceinline__ void ssm_prompt_unit(CArgs* A, int L, int unit, LAS unsigned char* wl, int lane) {
    const int b_ = unit / NG, g = unit % NG;
    LAS float* hre = (LAS float*)wl; LAS float* him = hre + 16 * 64; LAS float* ub = him + 16 * 64; LAS float* cre = ub + 256; LAS float* cim = cre + 16 * 64;
    const size_t gp = ((size_t)L * NG + g) * PS + lane;
    const float lr = ((const float*)(A->ws + WS_LAM))[2 * gp], li = ((const float*)(A->ws + WS_LAM))[2 * gp + 1];
    float Br[GC], Bi[GC];
#pragma unroll
    for (int c = 0; c < GC; c += 4) { const f32x4 r4 = *(const f32x4*)((const float*)(A->ws + WS_BBR) + gp * GC + c), i4 = *(const f32x4*)((const float*)(A->ws + WS_BBI) + gp * GC + c);
        Br[c] = r4.x; Br[c + 1] = r4.y; Br[c + 2] = r4.z; Br[c + 3] = r4.w; Bi[c] = i4.x; Bi[c + 1] = i4.y; Bi[c + 2] = i4.z; Bi[c + 3] = i4.w; }
#pragma unroll
    for (int c = 0; c < GC; ++c) { cre[c * 64 + lane] = A->in[17][(((size_t)L * NG + g) * GC + c) * PS + lane]; cim[c * 64 + lane] = A->in[18][(((size_t)L * NG + g) * GC + c) * PS + lane]; }
    const int t_ = lane >> 2, cq = lane & 3;
    float Dk[4];
#pragma unroll
    for (int i = 0; i < 4; ++i) Dk[i] = A->in[19][(size_t)L * DSSM + g * GC + 4 * cq + i];
    const bf16* Z = (const bf16*)(A->ws + WS_Z); bf16* Y = (bf16*)(A->ws + WS_YACT);
    float hr = 0.f, hi = 0.f;
    for (int blk = 0; blk < SEQ / 16; ++blk) {
        const int m0 = b_ * SEQ + blk * 16;
        { const v2u w = *(const v2u*)(Z + (size_t)(m0 + t_) * DIN + ZU + g * GC + 4 * cq); *(LAS f32x4*)(ub + t_ * 16 + 4 * cq) = (f32x4){blo(w.x), bhi(w.x), blo(w.y), bhi(w.y)}; }
        LDS_WAIT();
#pragma unroll 4
        for (int t = 0; t < 16; ++t) { float xr = 0.f, xi = 0.f;
#pragma unroll
            for (int c = 0; c < GC; c += 4) { const f32x4 u4 = *(const LAS f32x4*)(ub + t * 16 + c);
                xr += (Br[c] * u4.x + Br[c + 1] * u4.y) + (Br[c + 2] * u4.z + Br[c + 3] * u4.w); xi += (Bi[c] * u4.x + Bi[c + 1] * u4.y) + (Bi[c + 2] * u4.z + Bi[c + 3] * u4.w); }
            const float nr = lr * hr - li * hi + xr, ni = lr * hi + li * hr + xi; hr = nr; hi = ni; hre[t * 64 + lane] = hr; him[t * 64 + lane] = hi; }
        LDS_WAIT();
        float y[4] = {0.f, 0.f, 0.f, 0.f};
#pragma unroll 4
        for (int pq = 0; pq < 16; ++pq) { const f32x4 h4r = *(const LAS f32x4*)(hre + t_ * 64 + 4 * pq), h4i = *(const LAS f32x4*)(him + t_ * 64 + 4 * pq);
#pragma unroll
            for (int i = 0; i < 4; ++i) { const f32x4 cr = *(const LAS f32x4*)(cre + (4 * cq + i) * 64 + 4 * pq), ci = *(const LAS f32x4*)(cim + (4 * cq + i) * 64 + 4 * pq);
                y[i] += ((cr.x * h4r.x + cr.y * h4r.y) + (cr.z * h4r.z + cr.w * h4r.w)) - ((ci.x * h4i.x + ci.y * h4i.y) + (ci.z * h4i.z + ci.w * h4i.w)); } }
        { const f32x4 u4 = *(const LAS f32x4*)(ub + t_ * 16 + 4 * cq);
          const float o0 = gelu_tanh(y[0] + Dk[0] * u4.x), o1 = gelu_tanh(y[1] + Dk[1] * u4.y), o2 = gelu_tanh(y[2] + Dk[2] * u4.z), o3 = gelu_tanh(y[3] + Dk[3] * u4.w);
          v2u w; w.x = pk2(o0, o1); w.y = pk2(o2, o3); *(v2u*)(Y + (size_t)(m0 + t_) * DSSM + g * GC + 4 * cq) = w; }
        LDS_WAIT();
    }
    A->out[O_HRP + (((size_t)L * NBATCH + b_) * NG + g) * PS + lane] = hr; A->out[O_HIP + (((size_t)L * NBATCH + b_) * NG + g) * PS + lane] = hi;
}
__device__ __forceinline__ void ssm_sample_unit(CArgs* A, int L, int unit, int lane) {
    const int bs = unit / NG, g = unit % NG; const size_t gp = ((size_t)L * NG + g) * PS + lane;
    const float lr = ((const float*)(A->ws + WS_LAM))[2 * gp], li = ((const float*)(A->ws + WS_LAM))[2 * gp + 1];
    const bf16* zr = (const bf16*)(A->ws + WS_Z) + (size_t)(MP + bs) * DIN + ZU + g * GC; const v4u ua = *(const v4u*)zr, ub_ = *(const v4u*)(zr + 8);
    float u[GC];
#pragma unroll
    for (int e = 0; e < 4; ++e) { u[2 * e] = blo(ua[e]); u[2 * e + 1] = bhi(ua[e]); u[8 + 2 * e] = blo(ub_[e]); u[8 + 2 * e + 1] = bhi(ub_[e]); }
    float xr = 0.f, xi = 0.f;
#pragma unroll
    for (int c = 0; c < GC; ++c) { xr += ((const float*)(A->ws + WS_BBR))[gp * GC + c] * u[c]; xi += ((const float*)(A->ws + WS_BBI))[gp * GC + c] * u[c]; }
    const size_t si = (((size_t)L * SBATCH + bs) * NG + g) * PS + lane; const float h0r = A->in[6][si], h0i = A->in[7][si];
    const float hr = lr * h0r - li * h0i + xr, hi = lr * h0i + li * h0r + xi;
    A->out[O_HRS + si] = hr; A->out[O_HIS + si] = hi;
    float mine = 0.f;
#pragma unroll
    for (int c = 0; c < GC; ++c) { const size_t ci = (((size_t)L * NG + g) * GC + c) * PS + lane; const float yv = wave_sum(A->in[17][ci] * hr - A->in[18][ci] * hi); if (lane == c) mine = yv + A->in[19][(size_t)L * DSSM + g * GC + c] * u[c]; }
    if (lane < GC) ((bf16*)(A->ws + WS_YACT))[(size_t)(MP + bs) * DSSM + g * GC + lane] = (bf16)f2bf(gelu_tanh(mine));
}

__device__ __forceinline__ void load8(const bf16* p, float (&o)[8]) { const v4u a = *(const v4u*)p;
#pragma unroll
    for (int e = 0; e < 4; ++e) { o[2 * e] = blo(a[e]); o[2 * e + 1] = bhi(a[e]); } }
__device__ __forceinline__ void load8(const float* p, float (&o)[8]) { const f32x4 a = *(const f32x4*)p, b = *(const f32x4*)(p + 4); o[0] = a.x; o[1] = a.y; o[2] = a.z; o[3] = a.w; o[4] = b.x; o[5] = b.y; o[6] = b.z; o[7] = b.w; }
__device__ __forceinline__ void load2(const bf16* p, float& a, float& b) { const unsigned w = *(const unsigned*)p; a = blo(w); b = bhi(w); }
__device__ __forceinline__ void load2(const float* p, float& a, float& b) { const float2 w = *(const float2*)p; a = w.x; b = w.y; }
template <typename KT>
__device__ __forceinline__ void attn_task(const bf16* qrow, const KT* Kself, const KT* Vself, size_t kstride, int nkeys, float sink, const bf16* gate, bf16* orow, int lane) {
    const bool v0 = lane < nkeys, v1 = lane + 64 < nkeys;
    const KT* k0 = Kself - (size_t)(v0 ? lane : 0) * kstride; const KT* k1 = Kself - (size_t)(v1 ? lane + 64 : 0) * kstride;
    float s0 = 0.f, s1 = 0.f;
#pragma unroll 4
    for (int c = 0; c < 16; ++c) { float q8[8], a8[8], b8[8]; load8(qrow + 8 * c, q8); load8(k0 + 8 * c, a8); load8(k1 + 8 * c, b8);
#pragma unroll
        for (int e = 0; e < 8; ++e) { s0 += q8[e] * a8[e]; s1 += q8[e] * b8[e]; } }
    s0 = v0 ? s0 * ATT_SCALE : -INFINITY; s1 = v1 ? s1 * ATT_SCALE : -INFINITY;
    const float m = fmaxf(wave_max(fmaxf(s0, s1)), sink);
    const float p0 = v0 ? __expf(s0 - m) : 0.f, p1 = v1 ? __expf(s1 - m) : 0.f;
    const float den = wave_sum(p0 + p1) + __expf(sink - m);
    float o0 = 0.f, o1 = 0.f;
    const KT* vp = Vself + 2 * lane;
    const int n0 = nkeys < 64 ? nkeys : 64;
    for (int i = 0; i < n0; ++i) { const float pi = __builtin_bit_cast(float, __builtin_amdgcn_readlane(__builtin_bit_cast(int, p0), i)); float a, b; load2(vp - (size_t)i * kstride, a, b); o0 += pi * a; o1 += pi * b; }
    for (int i = 64; i < nkeys; ++i) { const float pi = __builtin_bit_cast(float, __builtin_amdgcn_readlane(__builtin_bit_cast(int, p1), i - 64)); float a, b; load2(vp - (size_t)i * kstride, a, b); o0 += pi * a; o1 += pi * b; }
    float ga, gb; load2(gate + 2 * lane, ga, gb);
    const float inv = 1.0f / den;
    *(unsigned*)(orow + 2 * lane) = pk2(o0 * inv * ga * sigm(ga), o1 * inv * gb * sigm(gb));
}
__device__ __forceinline__ void attn_phase(CArgs* A, int L, int gw, int NGW, int lane) {
    const bf16* Z = (const bf16*)(A->ws + WS_Z); bf16* CAT = (bf16*)(A->ws + WS_CAT);
    for (int task = gw; task < MR * NH; task += NGW) {
        const int row = task / NH, h = task % NH, kvh = h / (NH / NKV);
        const float sink = A->in[22][L * NH + h];
        const bf16* zr = Z + (size_t)row * DIN; bf16* orow = CAT + (size_t)row * DM + DSSM + h * HD;
        if (row < MP) { const int t = row & (SEQ - 1); attn_task<bf16>(zr + ZQ + h * HD, zr + ZK + kvh * HD, zr + ZV + kvh * HD, (size_t)DIN, t + 1 < WIN ? t + 1 : WIN, sink, zr + ZGA + h * HD, orow, lane); }
        else { const int bs = row - MP; const size_t wo = ((((size_t)L * SBATCH + bs) * WIN + (WIN - 1)) * NKV + kvh) * HD;
            attn_task<float>(zr + ZQ + h * HD, A->out + O_KS + wo, A->out + O_VS + wo, (size_t)(NKV * HD), WIN, sink, zr + ZGA + h * HD, orow, lane); }
    }
}
#ifndef MK_ONE_LAUNCH
#define MK_ONE_LAUNCH 0
#endif
__global__ void __launch_bounds__(NTHR, 2) fwd(Args args) {
    extern __shared__ __attribute__((aligned(16))) unsigned char lds_raw[];
    LAS unsigned char* lds = (LAS unsigned char*)lds_raw;
    const int tid0 = threadIdx.x;
    const int G = gridDim.x, NGW = G * NWAVES, NT = G * NTHR;
#define FRESH() int tid = threadIdx.x; asm volatile("" : "+v"(tid)); const int lane = tid & 63, wave = __builtin_amdgcn_readfirstlane(tid >> 6), gw = blockIdx.x * NWAVES + wave, gid = blockIdx.x * NTHR + tid; (void)lane; (void)wave; (void)gw; (void)gid
    volatile LAS unsigned* MISC = (volatile LAS unsigned*)(lds + MISC_OFF);
    for (int u = tid0; u < (LDS_BYTES - LDSCTL_OFF) / 4; u += NTHR) ((LAS unsigned*)(lds + LDSCTL_OFF))[u] = 0u;
    __syncthreads();
    const int lo = args.ph_lo, hi = args.ph_hi;
    XcdBarrier bar; bar.bar = (unsigned*)(args.ws + WS_CTL) + CW_BAR; bar.x = 0; bar.st = nullptr;
    if (hi - lo > 1) bar = xcd_barrier_post((unsigned*)(args.ws + WS_CTL) + CW_BAR, MISC + 8);
#define IN(k) (lo <= (k) && (k) < hi)
#define SEAM(k) do { if (hi > (k) + 1) xcd_barrier(bar); } while (0)

    if (IN(0)) { FRESH(); pro_phase(kargs(), lds, tid, lane, wave); SEAM(0); }
    for (int L = 0; L < DEPTH; ++L) {
        const int base = 1 + 6 * L;
        if (IN(base)) { FRESH(); norm_phase(kargs(), L, gw, NGW, lane); SEAM(base); }
        if (IN(base + 1)) { CArgs* A = kargs();
            pg8::Gemm g{(const pg8::bf16_t*)(A->ws + WS_H), (const pg8::bf16_t*)(A->ws + WS_WIN) + (size_t)L * DIN * DM, MPAD, DIN, DM}; pg8::StaticOrder S; S.init(MPAD, DIN, G, (int)blockIdx.x);
            pg8::EpiZ E{(pg8::bf16_t*)(A->ws + WS_Z), DIN};
            pg8::gemm_phase<pg8::EpiZ, pg8::StaticOrder, true, true>(lds, g, S, E);
            SEAM(base + 1);
        }
        if (IN(base + 2)) { FRESH();
            rope_phase(kargs(), L, gid, NT);
            if (wave < 2) { for (int u = blockIdx.x * 2 + wave; u < NBATCH * NG; u += G * 2) ssm_prompt_unit(kargs(), L, u, lds + wave * 32768, lane); }
            else { for (int u = blockIdx.x * 6 + (wave - 2); u < SBATCH * NG; u += G * 6) ssm_sample_unit(kargs(), L, u, lane); }
            SEAM(base + 2);
        }
        if (IN(base + 3)) { FRESH(); attn_phase(kargs(), L, gw, NGW, lane); SEAM(base + 3); }
        if (IN(base + 4)) { CArgs* A = kargs();
            pg8::Gemm g{(const pg8::bf16_t*)(A->ws + WS_YACT), (const pg8::bf16_t*)(A->ws + WS_WGLU) + (size_t)L * DSSM * DSSM, MPAD, DSSM, DSSM}; pg8::StaticOrder S; S.init(MPAD, DSSM, G, (int)blockIdx.x);
            pg8::EpiGlu E{(const pg8::bf16_t*)(A->ws + WS_YACT), DSSM, (const pg8::bf16_t*)(A->ws + WS_Z) + ZG, DIN, A->in[21] + (size_t)L * DSSM, (pg8::bf16_t*)(A->ws + WS_CAT), DM};
            pg8::gemm_phase<pg8::EpiGlu, pg8::StaticOrder, true, true>(lds, g, S, E);
            SEAM(base + 4);
        }
        if (IN(base + 5)) { CArgs* A = kargs();
            pg8::Gemm g{(const pg8::bf16_t*)(A->ws + WS_CAT), (const pg8::bf16_t*)(A->ws + WS_WOUT) + (size_t)L * DM * DM, MPAD, DM, DM}; pg8::StaticOrder S; S.init(MPAD, DM, G, (int)blockIdx.x);
            pg8::EpiOut E{A->out, DM, (const float*)(A->ws + WS_MOD) + (size_t)L * NB36 * 3 * DM + 2 * DM, 3 * DM, MR, MP, 11};
            pg8::gemm_phase<pg8::EpiOut, pg8::StaticOrder, true, true>(lds, g, S, E);
            SEAM(base + 5);
        }
    }
    if (IN(NPHASE - 1)) { FRESH(); final_phase(kargs(), gw, NGW, lane); }
#undef IN
#undef SEAM
}

extern "C" void kernel_launch(void* const* d_in, const int* in_sizes, int n_in, void* d_out, int out_size, void* d_ws, size_t ws_size, hipStream_t stream) {
    static int grid = 0;
    if (grid == 0) {
        if (n_in != 25 || (size_t)out_size != O_END || ws_size < WS_END) { fprintf(stderr, "kernel_launch: unexpected shapes (n_in %d out %d ws %zu); nothing launched\n", n_in, out_size, ws_size); grid = -1; return; }
        int dev = 0, cus = 0, per_cu = 0;
        if (hipGetDevice(&dev) != hipSuccess || hipDeviceGetAttribute(&cus, hipDeviceAttributeMultiprocessorCount, dev) != hipSuccess) { grid = -1; return; }
        if (hipFuncSetAttribute((const void*)fwd, hipFuncAttributeMaxDynamicSharedMemorySize, LDS_BYTES) != hipSuccess) { fprintf(stderr, "kernel_launch: hipFuncSetAttribute failed\n"); grid = -1; return; }
        if (hipOccupancyMaxActiveBlocksPerMultiprocessor(&per_cu, (const void*)fwd, NTHR, LDS_BYTES) != hipSuccess || per_cu < 1) fprintf(stderr, "kernel_launch: occupancy query says %d\n", per_cu);
        (void)hipGetLastError();
        grid = cus;
    }
    if (grid < 0) return;
    (void)hipMemsetAsync((char*)d_ws + WS_CTL, 0, CTL_ZERO_BYTES, stream);
    Args a{};
    for (int i = 0; i < 25; ++i) a.in[i] = (const float*)d_in[i];
    a.out = (float*)d_out; a.ws = (unsigned char*)d_ws;
#if MK_ONE_LAUNCH
    a.ph_lo = 0; a.ph_hi = NPHASE;
    hipLaunchKernelGGL(fwd, dim3(grid), dim3(NTHR), LDS_BYTES, stream, a);
#else
    for (int ph = 0; ph < NPHASE; ++ph) { a.ph_lo = ph; a.ph_hi = ph + 1; hipLaunchKernelGGL(fwd, dim3(grid), dim3(NTHR), LDS_BYTES, stream, a); }
#endif
}
```

```cpp
#include <hip/hip_runtime.h>
#include <cstdio>
#include <cstdint>
namespace pg8 {
#define PG8_LAS __attribute__((address_space(3)))
typedef unsigned short bf16_t;
typedef short bf16x8 __attribute__((ext_vector_type(8)));
typedef float f32x4 __attribute__((ext_vector_type(4)));
typedef unsigned u32x4 __attribute__((ext_vector_type(4)));
constexpr int BM = 256, BK = 64, HALF = 128, HTB = HALF * BK * 2  , STAGE_BYTES = 8 * HTB, NXCD = 8, WGM = 4;

__host__ __device__ __forceinline__ int lds_byte(int r, int c) { const int st = (r >> 4) * 2 + (c >> 5), rr = r & 15, cc = c & 31, ob = rr * 64 + cc * 2; return st * 1024 + (ob ^ (((ob >> 9) & 1) << 5)); }
__host__ __device__ __forceinline__ void stage_rc(int b, int& R, int& C) { const int st = b / 1024, sb = b % 1024, swz = sb ^ (((sb >> 9) & 1) << 5); R = (st >> 1) * 16 + swz / 64; C = (st & 1) * 32 + (swz % 64) / 2; }
__host__ __device__ __forceinline__ int perm32(int rho) { const int n = rho >> 4, i = rho & 15; return 8 * (i >> 2) + 4 * n + (i & 3); }

struct Unit { int pm, pn; };
struct Gemm { const bf16_t* A; const bf16_t* Bt; int M, N, K; };

struct StaticOrder {
    int nM, nN, nwg, G, c;
    __host__ __device__ void init(int M, int N, int G_, int c_) { nM = M / BM; nN = N / BM; nwg = nM * nN; G = G_; c = c_; }
    __host__ __device__ bool next(int i, Unit& u) const {
        const long L = (long)i * G + c; if (L >= nwg) return false;
        int wgid = (int)L; { const int q = nwg / NXCD, r = nwg % NXCD, xcd = wgid % NXCD, off = wgid / NXCD; wgid = (xcd < r ? xcd * (q + 1) : r * (q + 1) + (xcd - r) * q) + off; }
        const int nig = WGM * nN, gid = wgid / nig, fm = gid * WGM, gsz = (nM - fm) < WGM ? (nM - fm) : WGM;
        u.pm = fm + ((wgid % nig) % gsz); u.pn = (wgid % nig) / gsz; return true;
    }
    __device__ __forceinline__ void a_ready(const Unit&) const {}
    __device__ __forceinline__ void done(const Unit&) const {}
};

__device__ __forceinline__ unsigned cvt_pk_bf16(float lo, float hi) { unsigned r; asm volatile("v_cvt_pk_bf16_f32 %0, %1, %2" : "=v"(r) : "v"(lo), "v"(hi)); return r; }
typedef float f32x2 __attribute__((ext_vector_type(2)));
__device__ __forceinline__ float bf2f_lo(unsigned w) { return __uint_as_float(w << 16); }
__device__ __forceinline__ float bf2f_hi(unsigned w) { return __uint_as_float(w & 0xffff0000u); }
__device__ __forceinline__ float sigmoidf_(float a) { return __builtin_amdgcn_rcpf(1.0f + __expf(-a)); }
struct EpiZ {
    static constexpr bool PERM = true, AFTER_DRAIN = false;
    bf16_t* O; int ldc;
    __device__ __forceinline__ void operator()(const f32x4 (&acc)[2][2][4][2], const Unit& u, int wr, int wc, int fr, int fq) const {
        asm volatile("" : "+v"(fr), "+v"(fq));
        const int row0 = u.pm * BM + wr * 64 + fr, col0 = u.pn * BM + wc * 32 + 8 * fq;
#pragma unroll
        for (int ai = 0; ai < 2; ++ai)
#pragma unroll
            for (int m = 0; m < 4; ++m) { bf16_t* rowp = O + (size_t)(row0 + ai * HALF + m * 16) * ldc + col0;
#pragma unroll
                for (int bj = 0; bj < 2; ++bj) { const f32x4 v0 = acc[ai][bj][m][0], v1 = acc[ai][bj][m][1];
                    u32x4 w; w.x = cvt_pk_bf16(v0[0], v0[1]); w.y = cvt_pk_bf16(v0[2], v0[3]); w.z = cvt_pk_bf16(v1[0], v1[1]); w.w = cvt_pk_bf16(v1[2], v1[3]);
                    *(u32x4*)(rowp + bj * HALF) = w; } }
    }
};
struct EpiGlu {
    static constexpr bool PERM = true, AFTER_DRAIN = false;
    const bf16_t* Y; int ldy; const bf16_t* G; int ldg; const float* bias; bf16_t* O; int ldo;
    __device__ __forceinline__ void operator()(const f32x4 (&acc)[2][2][4][2], const Unit& u, int wr, int wc, int fr, int fq) const {
        asm volatile("" : "+v"(fr), "+v"(fq));
        const int row0 = u.pm * BM + wr * 64 + fr, col0 = u.pn * BM + wc * 32 + 8 * fq;
        f32x4 bv[2][2];
#pragma unroll
        for (int bj = 0; bj < 2; ++bj)
#pragma unroll
            for (int n = 0; n < 2; ++n) bv[bj][n] = *(const f32x4*)(bias + col0 + bj * HALF + 4 * n);
#pragma unroll
        for (int ai = 0; ai < 2; ++ai)
#pragma unroll
          for (int mb = 0; mb < 4; mb += 2) { u32x4 yv[2][2], gv[2][2];
#pragma unroll
            for (int m = 0; m < 2; ++m) { const size_t row = (size_t)(row0 + ai * HALF + (mb + m) * 16);
#pragma unroll
                for (int bj = 0; bj < 2; ++bj) { yv[m][bj] = *(const u32x4*)(Y + row * ldy + col0 + bj * HALF); gv[m][bj] = *(const u32x4*)(G + row * ldg + col0 + bj * HALF); } }
            asm volatile("" ::: "memory"); __builtin_amdgcn_sched_barrier(0);
#pragma unroll
            for (int m = 0; m < 2; ++m) { const size_t row = (size_t)(row0 + ai * HALF + (mb + m) * 16);
#pragma unroll
                for (int bj = 0; bj < 2; ++bj) { const int col = col0 + bj * HALF; const u32x4 y8 = yv[m][bj], g8 = gv[m][bj];
                    const f32x4 a0 = acc[ai][bj][mb + m][0] + bv[bj][0], a1 = acc[ai][bj][mb + m][1] + bv[bj][1];
                    float o[8];
#pragma unroll
                    for (int e = 0; e < 8; ++e) { const unsigned yw = y8[e >> 1], gw = g8[e >> 1];
                        const float yy = (e & 1) ? bf2f_hi(yw) : bf2f_lo(yw), gg = (e & 1) ? bf2f_hi(gw) : bf2f_lo(gw), a = e < 4 ? a0[e & 3] : a1[e & 3];
                        o[e] = yy * gg * __builtin_amdgcn_rcpf((1.0f + __expf(-a)) * (1.0f + __expf(-gg))); }
                    u32x4 w; w.x = cvt_pk_bf16(o[0], o[1]); w.y = cvt_pk_bf16(o[2], o[3]); w.z = cvt_pk_bf16(o[4], o[5]); w.w = cvt_pk_bf16(o[6], o[7]);
                    *(u32x4*)(O + row * ldo + col) = w; } }
            asm volatile("" ::: "memory"); }
    }
};
struct EpiOut {
    static constexpr bool PERM = false, AFTER_DRAIN = false;
    const float* Xin; float* X; int ldx; const float* gate; int gstride; int mrows; int mprompt; int seq_shift;
    __device__ __forceinline__ void operator()(const f32x4 (&acc)[2][2][4][2], const Unit& u, int wr, int wc, int fr, int fq) const {
        asm volatile("" : "+v"(fr), "+v"(fq));
        const int row0 = u.pm * BM + wr * 64 + fr, col0 = u.pn * BM + wc * 32 + 4 * fq;
        const int bi = (u.pm * BM) >> seq_shift;
        const float* gp = gate + (size_t)bi * gstride + col0;
        f32x4 gt[2][2];
#pragma unroll
        for (int bj = 0; bj < 2; ++bj)
#pragma unroll
            for (int n = 0; n < 2; ++n) gt[bj][n] = *(const f32x4*)(gp + bj * HALF + n * 16);
#pragma unroll
        for (int ai = 0; ai < 2; ++ai)
#pragma unroll
          for (int mb = 0; mb < 4; mb += 2) { f32x4 xv[2][2][2];
#pragma unroll
            for (int m = 0; m < 2; ++m) { const float* xi = Xin + (size_t)(row0 + ai * HALF + (mb + m) * 16) * ldx + col0;
#pragma unroll
                for (int bj = 0; bj < 2; ++bj)
#pragma unroll
                    for (int n = 0; n < 2; ++n) xv[m][bj][n] = *(const f32x4*)(xi + bj * HALF + n * 16); }
            asm volatile("" ::: "memory"); __builtin_amdgcn_sched_barrier(0);
#pragma unroll
            for (int m = 0; m < 2; ++m) { float* xp = X + (size_t)(row0 + ai * HALF + (mb + m) * 16) * ldx + col0;
#pragma unroll
                for (int bj = 0; bj < 2; ++bj)
#pragma unroll
                    for (int n = 0; n < 2; ++n) *(f32x4*)(xp + bj * HALF + n * 16) = xv[m][bj][n] + gt[bj][n] * acc[ai][bj][mb + m][n]; }
            asm volatile("" ::: "memory"); }
    }
};
struct EpiIn {
    static constexpr bool PERM = true, AFTER_DRAIN = false;
    bf16_t* O; int ldc; const float* CS; const float* SN; float* KW; float* VW;
    __device__ __forceinline__ void operator()(const f32x4 (&acc)[2][2][4][2], const Unit& u, int wr, int wc, int fr, int fq) const {
        asm volatile("" : "+v"(fr), "+v"(fq));
        const int row0 = u.pm * BM + wr * 64 + fr, col0 = u.pn * BM + wc * 32 + 8 * fq;
        const bool is_rot = u.pn >= 16 && u.pn < 26, is_k = u.pn >= 24 && u.pn < 26, is_v = u.pn >= 26 && u.pn < 28;
        const int gi = 4 * wc + fq;
#pragma unroll
        for (int ai = 0; ai < 2; ++ai) {
          f32x4 cc[1][4], ss[1][4];
          if (is_rot) {
#pragma unroll
                for (int m = 0; m < 4; ++m) { const int t = (row0 + ai * HALF + m * 16) & 2047; cc[0][m] = *(const f32x4*)(CS + t * 64 + 4 * gi); ss[0][m] = *(const f32x4*)(SN + t * 64 + 4 * gi); }
            asm volatile("" ::: "memory"); __builtin_amdgcn_sched_barrier(0); }
#pragma unroll
            for (int m = 0; m < 4; ++m) { const int row = row0 + ai * HALF + m * 16, t = row & 2047, b_ = row >> 11; bf16_t* rowp = O + (size_t)row * ldc;
                if (is_rot) { const f32x4 c4 = cc[0][m], s4 = ss[0][m];
#pragma unroll
                    for (int bj = 0; bj < 2; ++bj) { const f32x4 x1 = acc[ai][bj][m][0], x2 = acc[ai][bj][m][1]; const f32x4 o1 = x1 * c4 - x2 * s4, o2 = x2 * c4 + x1 * s4;
                        const int hb = u.pn * BM + bj * HALF; typedef unsigned u32x2_ __attribute__((ext_vector_type(2)));
                        u32x2_ w1, w2; w1.x = cvt_pk_bf16(o1[0], o1[1]); w1.y = cvt_pk_bf16(o1[2], o1[3]); w2.x = cvt_pk_bf16(o2[0], o2[1]); w2.y = cvt_pk_bf16(o2[2], o2[3]);
                        *(u32x2_*)(rowp + hb + 4 * gi) = w1; *(u32x2_*)(rowp + hb + 64 + 4 * gi) = w2;
                        if (is_k && t >= 2048 - 128) { float* kp = KW + (((size_t)b_ * 128 + (t - (2048 - 128))) * 4 + ((u.pn - 24) * 2 + bj)) * 128; *(f32x4*)(kp + 4 * gi) = o1; *(f32x4*)(kp + 64 + 4 * gi) = o2; } }
                } else {
#pragma unroll
                    for (int bj = 0; bj < 2; ++bj) { const f32x4 v0 = acc[ai][bj][m][0], v1 = acc[ai][bj][m][1];
                        u32x4 w; w.x = cvt_pk_bf16(v0[0], v0[1]); w.y = cvt_pk_bf16(v0[2], v0[3]); w.z = cvt_pk_bf16(v1[0], v1[1]); w.w = cvt_pk_bf16(v1[2], v1[3]);
                        *(u32x4*)(rowp + col0 + bj * HALF) = w;
                        if (is_v && t >= 2048 - 128) { float* vp = VW + (((size_t)b_ * 128 + (t - (2048 - 128))) * 4 + ((u.pn - 26) * 2 + bj)) * 128 + wc * 32 + 8 * fq; *(f32x4*)vp = v0; *(f32x4*)(vp + 4) = v1; } } } } }
    }
};
struct SplitOrder {
    int nM, nN, nwg, G, c; bool split;
    __host__ __device__ void init(int M, int N, int G_, int c_) { nM = M / BM; nN = N / BM; nwg = nM * nN; G = G_; c = c_; split = (G_ == 256) && (nwg % NXCD == 0) && ((nwg / NXCD) % 32 == 16); }
    __host__ __device__ static bool short_share(int G_, int c_) { return G_ == 256 ? (c_ % NXCD) >= NXCD / 2 : true; }
    __host__ __device__ bool next(int i, Unit& u) const {
        int wgid;
        if (split) { const int x = c % NXCD, j = c / NXCD, q = nwg / NXCD, big = q + 16, small = q - 16, off = 32 * i + j;
            if (off >= (x < NXCD / 2 ? big : small)) return false;
            wgid = (x < NXCD / 2 ? x * big : (NXCD / 2) * big + (x - NXCD / 2) * small) + off;
        } else { const long L = (long)i * G + c; if (L >= nwg) return false;
            wgid = (int)L; { const int q = nwg / NXCD, r = nwg % NXCD, xcd = wgid % NXCD, off = wgid / NXCD; wgid = (xcd < r ? xcd * (q + 1) : r * (q + 1) + (xcd - r) * q) + off; } }
        const int nig = WGM * nN, gid = wgid / nig, fm = gid * WGM, gsz = (nM - fm) < WGM ? (nM - fm) : WGM;
        u.pm = fm + ((wgid % nig) % gsz); u.pn = (wgid % nig) / gsz; return true;
    }
    __device__ __forceinline__ void a_ready(const Unit&) const {}
    __device__ __forceinline__ void done(const Unit&) const {}
};
template <class Epi, class Sched, bool ALIGN_EPI = false, bool SP2 = false>
__device__ __forceinline__ void gemm_phase(PG8_LAS unsigned char* lds, const Gemm g, const Sched& S, const Epi& E, int tid_in) {
    int tid_ = tid_in; asm volatile("" : "+v"(tid_));
    const int tid = tid_, wid = __builtin_amdgcn_readfirstlane(tid >> 6), lane = tid & 63, wr = wid >> 2, wc = wid & 3, fr = lane & 15, fq = lane >> 4;
    const int K = g.K, nt = K / BK;
    unsigned voffA[2], voffB[2];
#pragma unroll
    for (int i = 0; i < 2; ++i) { int R, C; stage_rc(tid * 16 + i * 8192, R, C); const int Rb = Epi::PERM ? ((R & ~31) + perm32(R & 31)) : R;
        voffA[i] = (unsigned)(R * K + C) * 2u; voffB[i] = (unsigned)(Rb * K + C) * 2u; }
    const size_t kstep = (size_t)(BK * 2);
    const size_t hstep = (size_t)HALF * K * 2;
    const size_t tstep = 2 * hstep;
    const unsigned ldsw = (unsigned)wid * 1024u;
    const int aoff = lds_byte(wr * 64 + fr, fq * 8), boff = lds_byte(wc * 32 + fr, fq * 8);
#define PG8_SA(b, h) (((b) * 2 + (h)) * HTB)
#define PG8_SB(b, h) ((4 + (b) * 2 + (h)) * HTB)
#define PG8_STAGE(bufoff, gbase, voff) do { _Pragma("unroll") for (int _i = 0; _i < 2; ++_i) \
        __builtin_amdgcn_global_load_lds((const unsigned*)((const char*)(gbase) + (voff)[_i]), (PG8_LAS unsigned*)(lds + (bufoff) + ldsw + _i * 8192), 16, 0, 0); } while (0)
#define PG8_LDA(dst, b, h) do { _Pragma("unroll") for (int m = 0; m < 4; ++m) _Pragma("unroll") for (int k = 0; k < 2; ++k) dst[m][k] = *(const PG8_LAS bf16x8*)(lds + PG8_SA(b, h) + aoff + m * 2048 + k * 1024); } while (0)
#define PG8_LDB(dst, b, h) do { _Pragma("unroll") for (int n = 0; n < 2; ++n) _Pragma("unroll") for (int k = 0; k < 2; ++k) dst[n][k] = *(const PG8_LAS bf16x8*)(lds + PG8_SB(b, h) + boff + n * 2048 + k * 1024); } while (0)
#define PG8_MMA(ai, bj, At, Bt) do { __builtin_amdgcn_s_setprio(1); _Pragma("unroll") for (int m = 0; m < 4; ++m) _Pragma("unroll") for (int n = 0; n < 2; ++n) _Pragma("unroll") for (int k = 0; k < 2; ++k) \
        acc[ai][bj][m][n] = __builtin_amdgcn_mfma_f32_16x16x32_bf16(Bt[n][k], At[m][k], acc[ai][bj][m][n], 0, 0, 0); __builtin_amdgcn_s_setprio(0); } while (0)
#define PG8_WAIT_V(n) asm volatile("s_waitcnt vmcnt(" #n ")" ::: "memory")
#define PG8_WAIT_L(n) asm volatile("s_waitcnt lgkmcnt(" #n ")" ::: "memory")
#define PG8_BAR __builtin_amdgcn_s_barrier()
#define PG8_SCHED __builtin_amdgcn_sched_barrier(0)
    Unit cur, nxt; int ui = 0;
    if (!S.next(0, cur)) return;
    f32x4 acc[2][2][4][2];
#pragma unroll
    for (int a = 0; a < 2; ++a)
#pragma unroll
        for (int b = 0; b < 2; ++b)
#pragma unroll
            for (int m = 0; m < 4; ++m)
#pragma unroll
                for (int n = 0; n < 2; ++n) acc[a][b][m][n] = (f32x4){0.f, 0.f, 0.f, 0.f};
    bf16x8 At[4][2], B0[2][2], B1[2][2];
    const char* cA = (const char*)g.A + (size_t)cur.pm * tstep; const char* cB = (const char*)g.Bt + (size_t)cur.pn * tstep;
    S.a_ready(cur);
    if constexpr (SP2) {
        PG8_STAGE(PG8_SB(0, 0), cB, voffB); PG8_STAGE(PG8_SB(0, 1), cB + hstep, voffB); PG8_STAGE(PG8_SA(0, 0), cA, voffA); PG8_STAGE(PG8_SA(0, 1), cA + hstep, voffA);
        if (wr == 1) PG8_BAR;
        PG8_WAIT_V(2); PG8_BAR;
        PG8_STAGE(PG8_SB(1, 0), cB + kstep, voffB); PG8_STAGE(PG8_SA(1, 0), cA + kstep, voffA); PG8_STAGE(PG8_SB(1, 1), cB + hstep + kstep, voffB);
        PG8_WAIT_V(6); PG8_BAR;
    } else {
        PG8_STAGE(PG8_SB(0, 0), cB, voffB); PG8_STAGE(PG8_SA(0, 0), cA, voffA); PG8_STAGE(PG8_SB(0, 1), cB + hstep, voffB); PG8_STAGE(PG8_SA(0, 1), cA + hstep, voffA);
        if (wr == 1) PG8_BAR;
        PG8_WAIT_V(4); PG8_BAR;
        PG8_STAGE(PG8_SB(1, 0), cB + kstep, voffB); PG8_STAGE(PG8_SA(1, 0), cA + kstep, voffA); PG8_STAGE(PG8_SB(1, 1), cB + hstep + kstep, voffB);
        PG8_WAIT_V(6); PG8_BAR;
    }
    for (;;) {
        const bool has_next = S.next(ui + 1, nxt);
        const char* nA = has_next ? (const char*)g.A + (size_t)nxt.pm * tstep : cA; const char* nB = has_next ? (const char*)g.Bt + (size_t)nxt.pn * tstep : cB;
        for (int t = 0; t < nt; t += 2) {
            const bool last = (t == nt - 2);
            const char* a1 = cA + (size_t)(t + 1) * kstep;
            const char* a2 = last ? nA : cA + (size_t)(t + 2) * kstep; const char* b2 = last ? nB : cB + (size_t)(t + 2) * kstep;
            const char* a3 = a2 + kstep; const char* b3 = b2 + kstep;
            if (last && has_next) S.a_ready(nxt);
            if constexpr (SP2) {
            PG8_LDB(B0, 0, 0); PG8_LDB(B1, 0, 1); PG8_SCHED; PG8_LDA(At, 0, 0); PG8_STAGE(PG8_SA(1, 1), a1 + hstep, voffA);
            PG8_WAIT_V(8); PG8_WAIT_L(0); PG8_BAR; PG8_MMA(0, 0, At, B0); PG8_MMA(0, 1, At, B1); PG8_BAR; PG8_SCHED;
            PG8_LDA(At, 0, 1); PG8_STAGE(PG8_SB(0, 0), b2, voffB); PG8_STAGE(PG8_SB(0, 1), b2 + hstep, voffB); PG8_STAGE(PG8_SA(0, 0), a2, voffA);
            PG8_WAIT_V(8); PG8_WAIT_L(0); PG8_BAR; PG8_MMA(1, 0, At, B0); PG8_MMA(1, 1, At, B1); PG8_BAR; PG8_SCHED;
            PG8_LDB(B0, 1, 0); PG8_LDB(B1, 1, 1); PG8_SCHED; PG8_LDA(At, 1, 0); PG8_STAGE(PG8_SA(0, 1), a2 + hstep, voffA);
            PG8_WAIT_V(8); PG8_WAIT_L(0); PG8_BAR; PG8_MMA(0, 0, At, B0); PG8_MMA(0, 1, At, B1); PG8_BAR; PG8_SCHED;
            PG8_LDA(At, 1, 1); PG8_STAGE(PG8_SB(1, 0), b3, voffB); PG8_STAGE(PG8_SB(1, 1), b3 + hstep, voffB); PG8_STAGE(PG8_SA(1, 0), a3, voffA);
            PG8_WAIT_V(8); PG8_WAIT_L(0); PG8_BAR; PG8_MMA(1, 0, At, B0); PG8_MMA(1, 1, At, B1); PG8_BAR; PG8_SCHED;
            } else {
            PG8_LDB(B0, 0, 0); PG8_SCHED; PG8_LDA(At, 0, 0); PG8_STAGE(PG8_SA(1, 1), a1 + hstep, voffA);
            PG8_WAIT_L(8); PG8_BAR; PG8_WAIT_L(0); PG8_MMA(0, 0, At, B0); PG8_BAR; PG8_SCHED;
            PG8_LDB(B1, 0, 1); PG8_STAGE(PG8_SB(0, 0), b2, voffB);
            PG8_BAR; PG8_WAIT_L(0); PG8_MMA(0, 1, At, B1); PG8_BAR;
            PG8_LDA(At, 0, 1); PG8_STAGE(PG8_SA(0, 0), a2, voffA);
            PG8_BAR; PG8_WAIT_L(0); PG8_MMA(1, 0, At, B0); PG8_BAR; PG8_SCHED;
            PG8_STAGE(PG8_SB(0, 1), b2 + hstep, voffB);
            PG8_WAIT_V(6); PG8_BAR; PG8_MMA(1, 1, At, B1); PG8_BAR;
            PG8_LDB(B0, 1, 0); PG8_SCHED; PG8_LDA(At, 1, 0); PG8_STAGE(PG8_SA(0, 1), a2 + hstep, voffA);
            PG8_WAIT_L(8); PG8_BAR; PG8_WAIT_L(0); PG8_MMA(0, 0, At, B0); PG8_BAR; PG8_SCHED;
            PG8_LDB(B1, 1, 1); PG8_STAGE(PG8_SB(1, 0), b3, voffB);
            PG8_BAR; PG8_WAIT_L(0); PG8_MMA(0, 1, At, B1); PG8_BAR;
            PG8_LDA(At, 1, 1); PG8_STAGE(PG8_SA(1, 0), a3, voffA);
            PG8_BAR; PG8_WAIT_L(0); PG8_MMA(1, 0, At, B0); PG8_BAR; PG8_SCHED;
            PG8_STAGE(PG8_SB(1, 1), b3 + hstep, voffB);
            PG8_WAIT_V(6); PG8_BAR; PG8_MMA(1, 1, At, B1); PG8_BAR;
            }
        }
        if constexpr (ALIGN_EPI) { if (wr == 0) PG8_BAR; }
        if constexpr (!Epi::AFTER_DRAIN) { E(acc, cur, wr, wc, fr, fq); S.done(cur); }
        if (!has_next) break;
#pragma unroll
        for (int a = 0; a < 2; ++a)
#pragma unroll
            for (int b = 0; b < 2; ++b)
#pragma unroll
                for (int m = 0; m < 4; ++m)
#pragma unroll
                    for (int n = 0; n < 2; ++n) acc[a][b][m][n] = (f32x4){0.f, 0.f, 0.f, 0.f};
        cur = nxt; cA = nA; cB = nB; ++ui;
        if constexpr (ALIGN_EPI) { if (wr == 1) PG8_BAR; }
    }
    PG8_WAIT_V(0);
    if constexpr (!ALIGN_EPI) { if (wr == 0) PG8_BAR; }
    PG8_BAR;
    if constexpr (Epi::AFTER_DRAIN) { E.fused(acc, cur, wr, wc, fr, fq, lds, wid, lane); S.done(cur); }
#undef PG8_SA
#undef PG8_SB
#undef PG8_STAGE
#undef PG8_LDA
#undef PG8_LDB
#undef PG8_MMA
#undef PG8_WAIT_V
#undef PG8_WAIT_L
#undef PG8_BAR
#undef PG8_SCHED
}
}
#define REP_ADA 1
#define REP_TR 1
#define REP_PREP 1
#define REP_ATS 1
#define REP_ATU 1
#define REP_AST 1
#define REP_ASB 1
constexpr int DM = 4096, NBATCH = 4, SEQ = 2048, DEPTH = 4, SBATCH = 32;
constexpr int MP = NBATCH * SEQ, MR = MP + SBATCH, MPAD = 8448;
constexpr int NG = 128, GC = 16, PS = 64, HD = 128, NH = 16, NKV = 4, WIN = 128, DSSM = 2048, DIN = 9216, NB36 = NBATCH + SBATCH;
constexpr int ZU = 0, ZG = 2048, ZQ = 4096, ZK = 6144, ZV = 6656, ZGA = 7168;
constexpr float EPS = 1e-6f, ATT_SCALE = 0.08838834764831845f;
constexpr size_t O_YP = 0, O_YS = 33554432, O_KP = 33685504, O_VP = 34734080, O_HRP = 35782656, O_HIP = 35913728, O_KS = 36044800, O_VS = 44433408, O_HRS = 52822016, O_HIS = 53870592, O_END = 54919168;
constexpr size_t MiB = 1u << 20;
constexpr size_t WS_CTL = 0, CTL_ZERO_BYTES = 1 * MiB;
constexpr size_t WS_WIN = 16 * MiB, WS_WGLU = 304 * MiB, WS_WOUT = 336 * MiB, WS_MOD = 464 * MiB, WS_H = 472 * MiB, WS_Z = 538 * MiB, WS_YACT = 688 * MiB, WS_CAT = 722 * MiB,
                 WS_LAM = 788 * MiB, WS_BBR = 789 * MiB, WS_BBI = 791 * MiB, WS_ROPE = 794 * MiB, WS_SG = 800 * MiB, WS_SF = 832 * MiB, WS_SM = 864 * MiB, WS_SPW = 872 * MiB, WS_SACT = 873 * MiB, WS_END = 880 * MiB;
static_assert(WS_WIN + (size_t)DEPTH * DIN * DM * 2 <= WS_WGLU && WS_WGLU + (size_t)DEPTH * DSSM * DSSM * 2 <= WS_WOUT && WS_WOUT + (size_t)DEPTH * DM * DM * 2 <= WS_MOD, "ws map 1");
static_assert(WS_MOD + (size_t)DEPTH * NB36 * 3 * DM * 4 <= WS_H && WS_H + (size_t)MPAD * DM * 2 <= WS_Z && WS_Z + (size_t)MPAD * DIN * 2 <= WS_YACT && WS_YACT + (size_t)MPAD * DSSM * 2 <= WS_CAT && WS_CAT + (size_t)MPAD * DM * 2 <= WS_LAM, "ws map 2");
constexpr int CW_BAR = 4096, CW_BAR2 = 8192;
constexpr int RING_BYTES = 131072, LDS_BYTES = 163840, LDSCTL_OFF = LDS_BYTES - 1024, MISC_OFF = LDSCTL_OFF + 320;
constexpr int NWAVES = 8, NTHR = 512;
constexpr int NPHASE = 3 + 5 * DEPTH;

#define GAS __attribute__((address_space(1)))
#define LAS __attribute__((address_space(3)))
typedef unsigned short bf16;
typedef unsigned v4u __attribute__((ext_vector_type(4)));
typedef unsigned v2u __attribute__((ext_vector_type(2)));
typedef float f32x4 __attribute__((ext_vector_type(4)));
#define LDS_WAIT() asm volatile("s_waitcnt lgkmcnt(0)" ::: "memory")
#define VM_WAIT() asm volatile("s_waitcnt vmcnt(0)" ::: "memory")
__device__ __forceinline__ unsigned f2bf(float f) { unsigned u = __builtin_bit_cast(unsigned, f); return (u + 0x7fffu + ((u >> 16) & 1u)) >> 16; }
__device__ __forceinline__ unsigned pk2(float lo, float hi) { return f2bf(lo) | (f2bf(hi) << 16); }
__device__ __forceinline__ float blo(unsigned w) { return __uint_as_float(w << 16); }
__device__ __forceinline__ float bhi(unsigned w) { return __uint_as_float(w & 0xffff0000u); }
__device__ __forceinline__ float bf1(bf16 h) { return __uint_as_float((unsigned)h << 16); }
__device__ __forceinline__ float sigm(float a) { return __builtin_amdgcn_rcpf(1.0f + __expf(-a)); }
__device__ __forceinline__ float gelu_tanh(float x) { const float p = fmaf(x * x, -0.10294324f, -2.30220819f); return x * __builtin_amdgcn_rcpf(1.0f + __builtin_amdgcn_exp2f(x * p)); }
template <int X> __device__ __forceinline__ float swz_xor(float v) { return __builtin_bit_cast(float, __builtin_amdgcn_ds_swizzle(__builtin_bit_cast(int, v), (X << 10) | 0x1f)); }
__device__ __forceinline__ float wave_sum(float v) {
    v += swz_xor<1>(v); v += swz_xor<2>(v); v += swz_xor<4>(v); v += swz_xor<8>(v); v += swz_xor<16>(v);
    auto rr = __builtin_amdgcn_permlane32_swap(__float_as_uint(v), __float_as_uint(v), false, false); return __uint_as_float(rr[0]) + __uint_as_float(rr[1]);
}
__device__ __forceinline__ float wave_max(float v) {
    v = fmaxf(v, swz_xor<1>(v)); v = fmaxf(v, swz_xor<2>(v)); v = fmaxf(v, swz_xor<4>(v)); v = fmaxf(v, swz_xor<8>(v)); v = fmaxf(v, swz_xor<16>(v));
    auto rr = __builtin_amdgcn_permlane32_swap(__float_as_uint(v), __float_as_uint(v), false, false); return fmaxf(__uint_as_float(rr[0]), __uint_as_float(rr[1]));
}
__device__ __forceinline__ int lane_id_fresh() { int l; asm volatile("v_mbcnt_lo_u32_b32 %0, -1, 0\n\tv_mbcnt_hi_u32_b32 %0, -1, %0" : "=v"(l)); return l; }
__device__ __forceinline__ void sincos_d(double x, double& s, double& c) {
    const double k = __builtin_rint(x * 0.63661977236758134308);
    double r = __builtin_fma(-k, 1.5707963267948966192, x); r = __builtin_fma(-k, 6.123233995736766036e-17, r);
    const double r2 = r * r;
    double ps = -1.0 / 1307674368000.0; ps = ps * r2 + 1.0 / 6227020800.0; ps = ps * r2 - 1.0 / 39916800.0; ps = ps * r2 + 1.0 / 362880.0; ps = ps * r2 - 1.0 / 5040.0; ps = ps * r2 + 1.0 / 120.0; ps = ps * r2 - 1.0 / 6.0; ps = ps * r2 * r + r;
    double pc = -1.0 / 87178291200.0; pc = pc * r2 + 1.0 / 479001600.0; pc = pc * r2 - 1.0 / 3628800.0; pc = pc * r2 + 1.0 / 40320.0; pc = pc * r2 - 1.0 / 720.0; pc = pc * r2 + 1.0 / 24.0; pc = pc * r2 - 0.5; pc = pc * r2 + 1.0;
    const int q = (int)((long long)k & 3);
    s = (q == 0) ? ps : (q == 1) ? pc : (q == 2) ? -ps : -pc;
    c = (q == 0) ? pc : (q == 1) ? -ps : (q == 2) ? -pc : ps;
}
__device__ __forceinline__ double exp_d(double x) {
    const double k = __builtin_rint(x * 1.4426950408889634074);
    double r = __builtin_fma(-k, 0.69314718055994528623, x); r = __builtin_fma(-k, 2.3190468138462995584e-17, r);
    double p = 1.0 / 6227020800.0; p = p * r + 1.0 / 479001600.0; p = p * r + 1.0 / 39916800.0; p = p * r + 1.0 / 3628800.0; p = p * r + 1.0 / 362880.0; p = p * r + 1.0 / 40320.0; p = p * r + 1.0 / 5040.0;
    p = p * r + 1.0 / 720.0; p = p * r + 1.0 / 120.0; p = p * r + 1.0 / 24.0; p = p * r + 1.0 / 6.0; p = p * r + 0.5; p = p * r + 1.0; p = p * r + 1.0;
    const long long e = (long long)k + 1023; return p * __builtin_bit_cast(double, (unsigned long long)e << 52);
}
__device__ const double ROPE_INV[64] = { 1.0, 0.8659643233600653, 0.7498942093324559, 0.6493816315762113, 0.5623413251903491, 0.4869675251658631, 0.4216965034285822, 0.3651741272548377, 0.31622776601683794, 0.27384196342643613, 0.23713737056616552, 0.2053525026457146, 0.1778279410038923, 0.1539926526059492, 0.1333521432163324, 0.11547819846894582, 0.1, 0.08659643233600653, 0.07498942093324558, 0.06493816315762113, 0.05623413251903491, 0.04869675251658631, 0.042169650342858224, 0.03651741272548377, 0.03162277660168379, 0.027384196342643614, 0.023713737056616554, 0.02053525026457146, 0.01778279410038923, 0.01539926526059492, 0.01333521432163324, 0.011547819846894581, 0.01, 0.008659643233600654, 0.007498942093324558, 0.006493816315762113, 0.005623413251903491, 0.004869675251658631, 0.004216965034285823, 0.003651741272548377, 0.0031622776601683794, 0.0027384196342643613, 0.0023713737056616554, 0.002053525026457146, 0.0017782794100389228, 0.001539926526059492, 0.001333521432163324, 0.0011547819846894581, 0.001, 0.0008659643233600654, 0.0007498942093324559, 0.0006493816315762113, 0.0005623413251903491, 0.0004869675251658631, 0.00042169650342858224, 0.0003651741272548377, 0.00031622776601683794, 0.0002738419634264361, 0.00023713737056616554, 0.0002053525026457146, 0.00017782794100389227, 0.0001539926526059492, 0.0001333521432163324, 0.00011547819846894582 };

#define XB_TMO      128
#define XB_XCNT(j)  (256  + 64 * (j))
#define XB_XSUB(j)  (1280 + 64 * (j))
#define XB_XGEN(j)  (2304 + 64 * (j))
#define XB_TOP      3328
#define XB_TOPGEN   3392
#define XCD_BAR_WORDS 3456
#define XB_SPIN_CAP (1u << 18)

__device__ __forceinline__ unsigned xb_ld(unsigned* p)              { return __hip_atomic_load(p, __ATOMIC_RELAXED, __HIP_MEMORY_SCOPE_AGENT); }
__device__ __forceinline__ unsigned xb_add(unsigned* p, unsigned v) { return __hip_atomic_fetch_add(p, v, __ATOMIC_RELAXED, __HIP_MEMORY_SCOPE_AGENT); }
__device__ __forceinline__ unsigned xb_xcc_id() { return (unsigned)__builtin_amdgcn_s_getreg((3 << 11) | 20) & 0xFu; }
#define XB_SPIN(cond, bar) do { unsigned _sp = 0; while (cond) { __builtin_amdgcn_s_sleep(1); \
    if ((++_sp & 255u) == 0u) { if (xb_ld(&(bar)[XB_TMO])) break; if (_sp > XB_SPIN_CAP) { atomicAdd(&(bar)[XB_TMO], 1u); break; } } } } while (0)

struct XcdBarrier {
    unsigned* bar; unsigned x;
    volatile LAS unsigned* st;
};

__device__ __forceinline__ XcdBarrier xcd_barrier_post(unsigned* bar, volatile LAS unsigned* st) {
    XcdBarrier b; b.bar = bar; b.x = xb_xcc_id(); b.st = st;
    if (threadIdx.x == 0) (void)xb_add(&bar[XB_XCNT(b.x)], 1u);
    return b;
}
__device__ __forceinline__ void xcd_barrier_complete(unsigned* bar, unsigned x, unsigned G, unsigned& nloc, unsigned& nx) {
    unsigned sum, cnt, mine, sp = 0u;
    for (;;) {
        sum = 0u; cnt = 0u; mine = 0u;
#pragma unroll
        for (unsigned j = 0; j < 16; ++j) { const unsigned c = xb_ld(&bar[XB_XCNT(j)]); sum += c; cnt += (c > 0u) ? 1u : 0u; mine = (j == x) ? c : mine; }
        if (sum == G) break;
        __builtin_amdgcn_s_sleep(1);
        if ((++sp & 255u) == 0u) { if (xb_ld(&bar[XB_TMO])) break; if (sp > XB_SPIN_CAP) { atomicAdd(&bar[XB_TMO], 1u); break; } }
    }
    nloc = mine > 0u ? mine : 1u; nx = cnt > 0u ? cnt : 1u;
}

__device__ __forceinline__ void xcd_barrier_n(const XcdBarrier& b, unsigned total) {
    asm volatile("s_waitcnt vmcnt(0)" ::: "memory");
    __syncthreads();
    if (threadIdx.x == 0) {
        unsigned* bar = b.bar;
        __builtin_amdgcn_s_waitcnt(0);
        unsigned nloc = b.st[0], nx = b.st[1];
        if (nloc == 0u) { xcd_barrier_complete(bar, b.x, total, nloc, nx); b.st[0] = nloc; b.st[1] = nx; }
        const unsigned old = xb_add(&bar[XB_XSUB(b.x)], 1u);
        const unsigned gen = old / nloc;
        if (old + 1u == (gen + 1u) * nloc) {
            __builtin_amdgcn_fence(__ATOMIC_RELEASE, "agent");
            asm volatile("s_waitcnt vmcnt(0)" ::: "memory");
            const unsigned og = xb_add(&bar[XB_TOP], 1u);
            const unsigned tg = og / nx;
            if (og + 1u == (tg + 1u) * nx) xb_add(&bar[XB_TOPGEN], 1u);
            else XB_SPIN(xb_ld(&bar[XB_TOPGEN]) == tg, bar);
            __builtin_amdgcn_fence(__ATOMIC_ACQUIRE, "agent");
            xb_add(&bar[XB_XGEN(b.x)], 1u);
            asm volatile("s_waitcnt vmcnt(0)" ::: "memory");
        } else {
            XB_SPIN(xb_ld(&bar[XB_XGEN(b.x)]) == gen, bar);
            __builtin_amdgcn_fence(__ATOMIC_ACQUIRE, "agent");
            asm volatile("s_waitcnt vmcnt(0)" ::: "memory");
        }
    }
    __syncthreads();
}
__device__ __forceinline__ void xcd_barrier(const XcdBarrier& b) { xcd_barrier_n(b, gridDim.x * gridDim.y * gridDim.z); }
struct Args { const float* in[25]; float* out; unsigned char* ws; int ph_lo, ph_hi; };
typedef const Args __attribute__((address_space(4))) CArgs;
__device__ __forceinline__ CArgs* kargs() { CArgs* p = (CArgs*)__builtin_amdgcn_kernarg_segment_ptr(); asm volatile("" : "+s"(p)); return p; }
constexpr size_t SG_BYTES = 65536, SF_BYTES = 65536, SM_BYTES = 16384, SPW_BYTES = 2048;
typedef short bf16x8 __attribute__((ext_vector_type(8)));
__device__ __forceinline__ void lam_pow(double ar, double ai, double dt, double d, double& re, double& im) { const double mag = exp_d(ar * dt * d); double s, c; sincos_d(ai * dt * d, s, c); re = mag * c; im = mag * s; }

__device__ __attribute__((noinline)) void ssm_prep_task(CArgs* A, int L, int g, LAS unsigned char* lds, int tid) {
    constexpr int CST = 68;
    LAS float* LPre = (LAS float*)lds; LAS float* LPim = LPre + 17 * 64; LAS float* Bre = LPim + 17 * 64; LAS float* Bim = Bre + 1024; LAS float* Cre = Bim + 1024; LAS float* Cim = Cre + 16 * CST; LAS float* Mk = Cim + 16 * CST; LAS float* Dk = Mk + 17 * 256;
    const size_t lg = (size_t)L * NG + g;
    bf16* GA = (bf16*)(A->ws + WS_SG + lg * SG_BYTES); bf16* FA = (bf16*)(A->ws + WS_SF + lg * SF_BYTES); bf16* AM = (bf16*)(A->ws + WS_SM + lg * SM_BYTES); float* PW = (float*)(A->ws + WS_SPW + lg * SPW_BYTES);
    __syncthreads();
    const float dt_f = A->in[14][lg], a64r = A->in[12][lg * PS + (tid & 63)], a64i = A->in[13][lg * PS + (tid & 63)];
    float aer[2], aei[2], ber[2], bei[2], ce[2], ci_[2];
#pragma unroll
    for (int e = 0; e < 2; ++e) { const int p = (tid >> 4) + 32 * e, cp = tid & 15; aer[e] = A->in[12][lg * PS + p]; aei[e] = A->in[13][lg * PS + p]; ber[e] = A->in[15][(lg * PS + p) * GC + cp]; bei[e] = A->in[16][(lg * PS + p) * GC + cp];
        ce[e] = A->in[17][lg * 1024 + tid + 512 * e]; ci_[e] = A->in[18][lg * 1024 + tid + 512 * e]; }
    const float dsk = A->in[19][(size_t)L * DSSM + g * GC + (tid & 15)];
    asm volatile("" ::: "memory"); __builtin_amdgcn_sched_barrier(0);
    const double dt = exp_d((double)dt_f);
    if (tid < 64) { const int p = tid; const double ar = a64r, ai = a64i; double l1r, l1i; lam_pow(ar, ai, dt, 1.0, l1r, l1i);
        double cr = 1.0, ci = 0.0;
#pragma unroll 1
        for (int d = 0; d <= 16; ++d) { LPre[d * 64 + p] = (float)cr; LPim[d * 64 + p] = (float)ci; const double nr = cr * l1r - ci * l1i, ni = cr * l1i + ci * l1r; cr = nr; ci = ni; }
#pragma unroll
        for (int k = 0; k < 4; ++k) { double lr, li; lam_pow(ar, ai, dt, (double)(16 << k), lr, li); PW[(p * 4 + k) * 2] = (float)lr; PW[(p * 4 + k) * 2 + 1] = (float)li; } }
#pragma unroll
    for (int e = 0; e < 2; ++e) { const int p = (tid >> 4) + 32 * e, cp = tid & 15; const double ar = aer[e], ai = aei[e];
        double lr, li; lam_pow(ar, ai, dt, 1.0, lr, li); const double nr = lr - 1.0, ni = li, den = ar * ar + ai * ai, qr = (nr * ar + ni * ai) / den, qi = (ni * ar - nr * ai) / den;
        const double br = ber[e], bi = bei[e]; Bre[p * 16 + cp] = (float)(qr * br - qi * bi); Bim[p * 16 + cp] = (float)(qr * bi + qi * br);
        const int i = tid + 512 * e; Cre[(i >> 6) * CST + (i & 63)] = ce[e]; Cim[(i >> 6) * CST + (i & 63)] = ci_[e]; }
    if (tid < 256) Mk[tid] = 0.f;
    if (tid < 16) Dk[tid] = dsk;
    __syncthreads();
    for (int i = tid; i < 4096; i += NTHR) { const int p = i & 63, hq = (i >> 6) & 1, ri = (i >> 7) & 1, d = i >> 8; const float lr = LPre[d * 64 + p], li = LPim[d * 64 + p];
        const f32x4 b0 = *(const LAS f32x4*)(Bre + p * 16 + 8 * hq), b1 = *(const LAS f32x4*)(Bre + p * 16 + 8 * hq + 4), c0 = *(const LAS f32x4*)(Bim + p * 16 + 8 * hq), c1 = *(const LAS f32x4*)(Bim + p * 16 + 8 * hq + 4);
        const f32x4 w0 = ri ? lr * c0 + li * b0 : lr * b0 - li * c0, w1 = ri ? lr * c1 + li * b1 : lr * b1 - li * c1;
        const int r = 15 - d, s8 = r >> 1, q = 2 * (r & 1) + hq, rho = p + 64 * ri, ti = rho >> 4, l = (rho & 15) + 16 * q;
        v4u w; w.x = pk2(w0.x, w0.y); w.y = pk2(w0.z, w0.w); w.z = pk2(w1.x, w1.y); w.w = pk2(w1.z, w1.w); *(v4u*)(GA + (size_t)((ti * 8 + s8) * 512 + l * 8)) = w; }
    for (int i = tid; i < 4096; i += NTHR) { const int c = i & 15, q = (i >> 4) & 3, ks = (i >> 6) & 3, sx = i >> 8, p0 = 16 * ks + 4 * q;
        const f32x4 lr = *(const LAS f32x4*)(LPre + (sx + 1) * 64 + p0), li = *(const LAS f32x4*)(LPim + (sx + 1) * 64 + p0), cr = *(const LAS f32x4*)(Cre + c * CST + p0), ci = *(const LAS f32x4*)(Cim + c * CST + p0);
        const f32x4 vre = cr * lr - ci * li, vim = -(cr * li + ci * lr);
        v4u w; w.x = pk2(vre.x, vre.y); w.y = pk2(vre.z, vre.w); w.z = pk2(vim.x, vim.y); w.w = pk2(vim.z, vim.w); *(v4u*)(FA + (size_t)((sx * 4 + ks) * 512 + (c + 16 * q) * 8)) = w; }
    for (int i = tid; i < 1024; i += NTHR) { const int d = i >> 6, c = (i >> 2) & 15, cq = i & 3; f32x4 m = (f32x4){0.f, 0.f, 0.f, 0.f};
#pragma unroll 2
        for (int pq = 0; pq < PS / 4; ++pq) { const f32x4 lr = *(const LAS f32x4*)(LPre + d * 64 + 4 * pq), li = *(const LAS f32x4*)(LPim + d * 64 + 4 * pq), cr = *(const LAS f32x4*)(Cre + c * CST + 4 * pq), ci = *(const LAS f32x4*)(Cim + c * CST + 4 * pq);
            const f32x4 ar_ = cr * lr - ci * li, ai_ = cr * li + ci * lr;
#pragma unroll
            for (int e = 0; e < 4; ++e) { const f32x4 br = *(const LAS f32x4*)(Bre + (4 * pq + e) * 16 + 4 * cq), bi = *(const LAS f32x4*)(Bim + (4 * pq + e) * 16 + 4 * cq); m += ar_[e] * br - ai_[e] * bi; } }
        if (d == 0 && (c >> 2) == cq) { const float dk = Dk[c]; m.x += (c & 3) == 0 ? dk : 0.f; m.y += (c & 3) == 1 ? dk : 0.f; m.z += (c & 3) == 2 ? dk : 0.f; m.w += (c & 3) == 3 ? dk : 0.f; }
        *(LAS f32x4*)(Mk + (d + 1) * 256 + c * 16 + 4 * cq) = m; }
    __syncthreads();
    for (int i = tid; i < 16 * 64; i += NTHR) { const int d = i >> 6, l = i & 63, c = l & 15, q = l >> 4, th = q >> 1; const LAS float* mp = Mk + (d + 1 - th) * 256 + c * 16 + 8 * (q & 1);
        const f32x4 m0 = *(const LAS f32x4*)mp, m1 = *(const LAS f32x4*)(mp + 4); v4u w; w.x = pk2(m0.x, m0.y); w.y = pk2(m0.z, m0.w); w.z = pk2(m1.x, m1.y); w.w = pk2(m1.z, m1.w); *(v4u*)(AM + (size_t)i * 8) = w; }
    __syncthreads();
}

template <int CTRL> __device__ __forceinline__ float dppf(float x) { return __builtin_bit_cast(float, __builtin_amdgcn_update_dpp(0, __builtin_bit_cast(int, x), CTRL, 0xf, 0xf, true)); }
#define DPP_SHR(n) (0x110 + (n))
#define DPP_SHL(n) (0x100 + (n))
#define MFMA16(a, b, c) __builtin_amdgcn_mfma_f32_16x16x32_bf16((a), (b), (c), 0, 0, 0)
constexpr int SL_G = 0, SL_F = 65536, SL_M = 131072, SL_PW = 147456;
constexpr int SL_X = 149504;
#define SSM_BAR() do { asm volatile("s_waitcnt lgkmcnt(0)" ::: "memory"); __builtin_amdgcn_s_barrier(); asm volatile("" ::: "memory"); } while (0)
__device__ __forceinline__ void ssm_mfma_unit8(CArgs* A, int L, int g, int bp, LAS unsigned char* lds, int lane, int wave) {
    const int n = lane & 15, q = lane >> 4, bb = wave >> 2, wq = wave & 3, b_ = 2 * bp + bb;
    const bf16* zb = (const bf16*)(A->ws + WS_Z) + (size_t)(b_ * SEQ) * DIN + ZU + g * GC + 8 * (q & 1) + (size_t)(16 * n + (q >> 1)) * DIN;
    bf16* yb = (bf16*)(A->ws + WS_YACT) + (size_t)(b_ * SEQ + 16 * n) * DSSM + g * GC + 4 * q;
    const LAS bf16x8* GAl = (const LAS bf16x8*)(lds + SL_G) + lane; const LAS bf16x8* FAl = (const LAS bf16x8*)(lds + SL_F) + lane; const LAS bf16x8* AMl = (const LAS bf16x8*)(lds + SL_M) + lane;
    const LAS f32x4* PWl = (const LAS f32x4*)(lds + SL_PW);
    LAS bf16x8* XH = (LAS bf16x8*)(lds + SL_X) + bb * 256 + lane;
    f32x4 cXr = (f32x4){0.f, 0.f, 0.f, 0.f}, cXi = cXr;
    f32x4 pw0[4], pw1[4];
#pragma unroll
    for (int r = 0; r < 4; ++r) { pw0[r] = PWl[(16 * wq + 4 * q + r) * 2]; pw1[r] = PWl[(16 * wq + 4 * q + r) * 2 + 1]; }
    bf16x8 Uc[8], Un[8];
#pragma unroll
    for (int s8 = 0; s8 < 8; ++s8) Uc[s8] = *(const bf16x8*)(zb + (size_t)(2 * s8) * DIN);
    for (int blk = 0; blk < SEQ / 256; ++blk) {
        const int nb = blk + 1 < SEQ / 256 ? blk + 1 : blk;
#pragma unroll
        for (int s8 = 0; s8 < 8; ++s8) Un[s8] = *(const bf16x8*)(zb + (size_t)(256 * nb + 2 * s8) * DIN);
        f32x4 Zr = (f32x4){0.f, 0.f, 0.f, 0.f}, Zi = Zr;
#pragma unroll
        for (int s8 = 0; s8 < 8; ++s8) { Zr = MFMA16(GAl[(wq * 8 + s8) * 64], Uc[s8], Zr); Zi = MFMA16(GAl[((wq + 4) * 8 + s8) * 64], Uc[s8], Zi); }
        float hr[4], hi[4];
#pragma unroll
        for (int r = 0; r < 4; ++r) { const f32x4 w0 = pw0[r], w1 = pw1[r];
            float xr = Zr[r], xi = Zi[r];
            const float cr = dppf<DPP_SHL(15)>(cXr[r]), ci = dppf<DPP_SHL(15)>(cXi[r]);
            xr += w0.x * cr - w0.y * ci; xi += w0.x * ci + w0.y * cr;
            { const float pr = dppf<DPP_SHR(1)>(xr), pi = dppf<DPP_SHR(1)>(xi); xr += w0.x * pr - w0.y * pi; xi += w0.x * pi + w0.y * pr; }
            { const float pr = dppf<DPP_SHR(2)>(xr), pi = dppf<DPP_SHR(2)>(xi); xr += w0.z * pr - w0.w * pi; xi += w0.z * pi + w0.w * pr; }
            { const float pr = dppf<DPP_SHR(4)>(xr), pi = dppf<DPP_SHR(4)>(xi); xr += w1.x * pr - w1.y * pi; xi += w1.x * pi + w1.y * pr; }
            { const float pr = dppf<DPP_SHR(8)>(xr), pi = dppf<DPP_SHR(8)>(xi); xr += w1.z * pr - w1.w * pi; xi += w1.z * pi + w1.w * pr; }
            hr[r] = dppf<DPP_SHR(1)>(xr) + cr; hi[r] = dppf<DPP_SHR(1)>(xi) + ci; cXr[r] = xr; cXi[r] = xi; }
        SSM_BAR();
        XH[64 * wq] = __builtin_bit_cast(bf16x8, (v4u){pk2(hr[0], hr[1]), pk2(hr[2], hr[3]), pk2(hi[0], hi[1]), pk2(hi[2], hi[3])});
        SSM_BAR();
        bf16x8 Hb[4];
#pragma unroll
        for (int ks = 0; ks < 4; ++ks) Hb[ks] = XH[64 * ks];
        f32x4 Y[4];
#pragma unroll
        for (int sl = 0; sl < 4; ++sl) { Y[sl] = (f32x4){0.f, 0.f, 0.f, 0.f};
#pragma unroll
            for (int ks = 0; ks < 4; ++ks) Y[sl] = MFMA16(FAl[((wq + 4 * sl) * 4 + ks) * 64], Hb[ks], Y[sl]); }
#pragma unroll
        for (int sl = 0; sl < 4; ++sl)
#pragma unroll
            for (int s8 = 0; s8 < 8; ++s8) { const int s = wq + 4 * sl; if (2 * s8 <= s) Y[sl] = MFMA16(AMl[(s - 2 * s8) * 64], Uc[s8], Y[sl]); }
#pragma unroll
        for (int sl = 0; sl < 4; ++sl) { const int s = wq + 4 * sl; v2u w; w.x = pk2(gelu_tanh(Y[sl][0]), gelu_tanh(Y[sl][1])); w.y = pk2(gelu_tanh(Y[sl][2]), gelu_tanh(Y[sl][3]));
            *(v2u*)(yb + (size_t)(256 * blk + s) * DSSM) = w; }
#pragma unroll
        for (int s8 = 0; s8 < 8; ++s8) Uc[s8] = Un[s8];
    }
    if (n == 15) { float* hr_o = A->out + O_HRP + (((size_t)L * NBATCH + b_) * NG + g) * PS; float* hi_o = A->out + O_HIP + (((size_t)L * NBATCH + b_) * NG + g) * PS;
        *(f32x4*)(hr_o + 16 * wq + 4 * q) = cXr; *(f32x4*)(hi_o + 16 * wq + 4 * q) = cXi; }
}
__device__ __forceinline__ void ssm_mfma_phase(CArgs* A, int L, LAS unsigned char* lds, int tid, int lane, int wave) {
    const int Gq = (int)gridDim.x, vcu = (Gq % 8 == 0) ? ((int)blockIdx.x % 8) * (Gq / 8) + (int)blockIdx.x / 8 : (int)blockIdx.x;
    for (int u = vcu; u < 2 * NG; u += gridDim.x) { const int g = u >> 1, bp = u & 1; const size_t lg = (size_t)L * NG + g;
        __syncthreads();
        {   const unsigned char* sG = A->ws + WS_SG + lg * SG_BYTES; const unsigned char* sF = A->ws + WS_SF + lg * SF_BYTES; const unsigned char* sM = A->ws + WS_SM + lg * SM_BYTES; const unsigned char* sP = A->ws + WS_SPW + lg * SPW_BYTES;
#pragma unroll
            for (int i = 0; i < 8; ++i) { const int o = (i * NWAVES + wave) * 1024;
                __builtin_amdgcn_global_load_lds((const unsigned*)(sG + o + lane * 16), (LAS unsigned*)(lds + SL_G + o), 16, 0, 0);
                __builtin_amdgcn_global_load_lds((const unsigned*)(sF + o + lane * 16), (LAS unsigned*)(lds + SL_F + o), 16, 0, 0); }
#pragma unroll
            for (int i = 0; i < 2; ++i) { const int o = (i * NWAVES + wave) * 1024; __builtin_amdgcn_global_load_lds((const unsigned*)(sM + o + lane * 16), (LAS unsigned*)(lds + SL_M + o), 16, 0, 0); }
            if (wave < 2) __builtin_amdgcn_global_load_lds((const unsigned*)(sP + wave * 1024 + lane * 16), (LAS unsigned*)(lds + SL_PW + wave * 1024), 16, 0, 0);
            asm volatile("s_waitcnt vmcnt(0)" ::: "memory");
        }
        __syncthreads();
        ssm_mfma_unit8(A, L, g, bp, lds, lane, wave);
    }
    __syncthreads();
}
constexpr int TR_SCR = 64 * 65 * 4;
__device__ __forceinline__ int rot_slot(int n) { if (n < ZQ || n >= ZV) return n; const int t = n & 127, hb = n & ~127; return hb + (t < 64 ? 8 * (t >> 2) + (t & 3) : 8 * ((t - 64) >> 2) + 4 + (t & 3)); }
__device__ __forceinline__ int rot_true(int s) { if (s < ZQ || s >= ZV) return s; const int t = s & 127, hb = s & ~127, gi = t >> 3, e = t & 7; return hb + (e < 4 ? 4 * gi + e : 64 + 4 * gi + (e - 4)); }
template <bool ROT>
__device__ __forceinline__ void transpose_item(const float* W, int K, int N, bf16* WT, LAS float* scr, int item, int lane) {
    const int nblk = N / 64, kb = item / nblk, nb = item % nblk, k0 = 64 * kb, n0 = 64 * nb;
    f32x4 v[16];
#pragma unroll
    for (int i = 0; i < 16; ++i) v[i] = *(const f32x4*)(W + (size_t)(k0 + 4 * i + (lane >> 4)) * N + n0 + 4 * (lane & 15));
#pragma unroll
    for (int i = 0; i < 16; ++i) { LAS float* p = scr + (4 * i + (lane >> 4)) * 65 + 4 * (lane & 15); p[0] = v[i].x; p[1] = v[i].y; p[2] = v[i].z; p[3] = v[i].w; }
    LDS_WAIT(); asm volatile("" ::: "memory");
    const int c = lane & 7;
#pragma unroll
    for (int jj = 0; jj < 8; ++jj) { const int n = (lane >> 3) + 8 * jj; const LAS float* s = scr + (8 * c) * 65 + n;
        v4u o; o.x = pk2(s[0 * 65], s[1 * 65]); o.y = pk2(s[2 * 65], s[3 * 65]); o.z = pk2(s[4 * 65], s[5 * 65]); o.w = pk2(s[6 * 65], s[7 * 65]);
        *(v4u*)(WT + (size_t)(ROT ? rot_slot(n0 + n) : n0 + n) * K + k0 + 8 * c) = o; }
    LDS_WAIT(); asm volatile("" ::: "memory");
}
__device__ __forceinline__ void pre_phase(CArgs* A, int gid, int NT) {
    bf16* S = (bf16*)(A->ws + WS_SACT);
    for (int i = gid; i < 48 * DM; i += NT) { const int r = i / DM, k = i % DM; float c = 0.f;
        if (r < NBATCH) c = A->in[2][(size_t)r * DM + k]; else if (r < NB36) c = A->in[3][(size_t)(r - NBATCH) * DM + k];
        const float s = r < NB36 ? c * sigm(c) : 0.f; const unsigned h = f2bf(s); const float rem = s - __uint_as_float(h << 16);
        S[i] = (bf16)h; S[48 * DM + i] = (bf16)f2bf(rem); }
}
#define ADA_NT 6
__device__ __forceinline__ void ada_item(CArgs* A, int item, LAS unsigned char* lds, int tid, int lane, int wave) {
    constexpr int NTL = ADA_NT, NCOL = 16 * NTL, NIT = 3 * DM / NCOL;
    const int L = item / NIT, n0 = (item % NIT) * NCOL, r = lane & 15, q = lane >> 4, kbeg = wave * (DM / NWAVES);
    const float* W = A->in[8] + (size_t)L * DM * 3 * DM + (size_t)(kbeg + 8 * q) * 3 * DM + n0 + r;
    const bf16* Sh = (const bf16*)(A->ws + WS_SACT) + (size_t)r * DM + kbeg + 8 * q; const bf16* Sl = Sh + 48 * DM;
    f32x4 acc[3][NTL];
#pragma unroll
    for (int mt = 0; mt < 3; ++mt)
#pragma unroll
        for (int nt = 0; nt < NTL; ++nt) acc[mt][nt] = (f32x4){0.f, 0.f, 0.f, 0.f};
    float wv[NTL][8];
#pragma unroll
    for (int nt = 0; nt < NTL; ++nt)
#pragma unroll
        for (int j = 0; j < 8; ++j) wv[nt][j] = W[(size_t)j * 3 * DM + 16 * nt];
    for (int ks = 0; ks < DM / NWAVES / 32; ++ks) {
        bf16x8 bh[NTL], bl[NTL];
#pragma unroll
        for (int nt = 0; nt < NTL; ++nt) { v4u h, l;
#pragma unroll
            for (int e = 0; e < 4; ++e) { const float w0 = wv[nt][2 * e], w1 = wv[nt][2 * e + 1]; const unsigned h0 = f2bf(w0), h1 = f2bf(w1);
                h[e] = h0 | (h1 << 16); l[e] = pk2(w0 - __uint_as_float(h0 << 16), w1 - __uint_as_float(h1 << 16)); }
            bh[nt] = __builtin_bit_cast(bf16x8, h); bl[nt] = __builtin_bit_cast(bf16x8, l); }
        const int kn = ks + 1 < DM / NWAVES / 32 ? ks + 1 : ks;
#pragma unroll
        for (int nt = 0; nt < NTL; ++nt)
#pragma unroll
            for (int j = 0; j < 8; ++j) wv[nt][j] = W[(size_t)(32 * kn + j) * 3 * DM + 16 * nt];
        bf16x8 ah[3], al[3];
#pragma unroll
        for (int mt = 0; mt < 3; ++mt) { ah[mt] = *(const bf16x8*)(Sh + (size_t)(16 * mt) * DM + 32 * ks); al[mt] = *(const bf16x8*)(Sl + (size_t)(16 * mt) * DM + 32 * ks); }
#pragma unroll
        for (int mt = 0; mt < 3; ++mt)
#pragma unroll
            for (int nt = 0; nt < NTL; ++nt) { acc[mt][nt] = MFMA16(ah[mt], bh[nt], acc[mt][nt]); acc[mt][nt] = MFMA16(ah[mt], bl[nt], acc[mt][nt]); acc[mt][nt] = MFMA16(al[mt], bh[nt], acc[mt][nt]); }
    }
    __syncthreads();
    LAS f32x4* Pp = (LAS f32x4*)lds;
#pragma unroll
    for (int mt = 0; mt < 3; ++mt)
#pragma unroll
        for (int nt = 0; nt < NTL; ++nt) Pp[(wave * 3 * NTL + mt * NTL + nt) * 64 + lane] = acc[mt][nt];
    __syncthreads();
    float* mod = (float*)(A->ws + WS_MOD) + (size_t)L * NB36 * 3 * DM; const float* bias = A->in[9] + (size_t)L * 3 * DM;
    for (int e = tid; e < 3 * NTL * 64; e += NTHR) { const int t = e >> 6, l = e & 63, mt = t / NTL, nt = t % NTL; f32x4 s = Pp[t * 64 + l];
#pragma unroll
        for (int w = 1; w < NWAVES; ++w) s += Pp[(w * 3 * NTL + t) * 64 + l];
        const int n = n0 + 16 * nt + (l & 15), m0 = 16 * mt + 4 * (l >> 4); const float bb = bias[n];
#pragma unroll
        for (int i = 0; i < 4; ++i) if (m0 + i < NB36) mod[(size_t)(m0 + i) * 3 * DM + n] = s[i] + bb; }
}

__device__ __forceinline__ void pro_phase(CArgs* A, LAS unsigned char* lds, int tid, int lane, int wave) {
    const int bx = blockIdx.x, G = gridDim.x;
#pragma unroll 1
    for (int rep = 0; rep < REP_ADA; ++rep)
    for (int it = bx; it < DEPTH * (3 * DM / (16 * ADA_NT)); it += G) ada_item(A, it, lds, tid, lane, wave);
    __syncthreads();
#pragma unroll 1
    for (int rep = 0; rep < REP_TR; ++rep)
    {
        LAS float* scr = (LAS float*)(lds + wave * TR_SCR);
        const int tw = bx * NWAVES + wave, NTW = G * NWAVES;
        constexpr int I_IN = (DM / 64) * (DIN / 64), I_GLU = (DSSM / 64) * (DSSM / 64), I_OUT = (DM / 64) * (DM / 64), I_L = I_IN + I_GLU + I_OUT;
        for (int it = tw; it < DEPTH * I_L; it += NTW) {
            const int L = it / I_L; int r = it % I_L;
            if (r < I_IN) { transpose_item<true>(A->in[11] + (size_t)L * DM * DIN, DM, DIN, (bf16*)(A->ws + WS_WIN) + (size_t)L * DIN * DM, scr, r, lane); continue; } r -= I_IN;
            if (r < I_GLU) { transpose_item<false>(A->in[20] + (size_t)L * DSSM * DSSM, DSSM, DSSM, (bf16*)(A->ws + WS_WGLU) + (size_t)L * DSSM * DSSM, scr, r, lane); continue; } r -= I_GLU;
            transpose_item<false>(A->in[23] + (size_t)L * DM * DM, DM, DM, (bf16*)(A->ws + WS_WOUT) + (size_t)L * DM * DM, scr, r, lane);
        }
    }
    const int gid = bx * NTHR + tid, NT = G * NTHR;
    for (int it = gid; it < DEPTH * NG * PS; it += NT) {
        const double ar = A->in[12][it], ai = A->in[13][it], dt = exp_d((double)A->in[14][it / PS]);
        const double mag = exp_d(ar * dt); double sn, cs; sincos_d(ai * dt, sn, cs);
        const double lr = mag * cs, li = mag * sn, nr = lr - 1.0, ni = li, den = ar * ar + ai * ai, qr = (nr * ar + ni * ai) / den, qi = (ni * ar - nr * ai) / den;
        ((float*)(A->ws + WS_LAM))[2 * it] = (float)lr; ((float*)(A->ws + WS_LAM))[2 * it + 1] = (float)li;
#pragma unroll
        for (int c = 0; c < GC; ++c) { const double br = A->in[15][(size_t)it * GC + c], bi = A->in[16][(size_t)it * GC + c];
            ((float*)(A->ws + WS_BBR))[(size_t)it * GC + c] = (float)(qr * br - qi * bi); ((float*)(A->ws + WS_BBI))[(size_t)it * GC + c] = (float)(qr * bi + qi * br); }
    }
    for (int it = gid; it < (SEQ + 1) * 64; it += NT) { const int pi = it >> 6, i = it & 63; const double pos = pi < SEQ ? (double)pi : 8192.0; double sn, cs; sincos_d(pos * ROPE_INV[i], sn, cs);
        ((float*)(A->ws + WS_ROPE))[it] = (float)cs; ((float*)(A->ws + WS_ROPE))[(SEQ + 1) * 64 + it] = (float)sn; }
}

__device__ __forceinline__ void norm_phase(CArgs* A, int L, int row_lo, int row_hi, int gw, int NGW, int lane) {
    bf16* H = (bf16*)(A->ws + WS_H); const float* modL = (const float*)(A->ws + WS_MOD) + (size_t)L * NB36 * 3 * DM; const float* g = A->in[10] + (size_t)L * DM;
    for (int pr = (row_lo >> 1) + gw; 2 * pr + 1 < (row_hi < MP ? row_hi : MP); pr += NGW) { const int row = 2 * pr;
        const float* md = modL + (size_t)(row / SEQ) * 3 * DM;
        const float* xrow = L == 0 ? A->in[0] + (size_t)row * DM : A->out + (size_t)row * DM;
        const f32x4* xr = (const f32x4*)xrow + lane; f32x4 v0[16], v1[16]; float s0 = 0.f, s1 = 0.f;
#pragma unroll
        for (int j = 0; j < 16; ++j) { v0[j] = xr[64 * j]; v1[j] = xr[DM / 4 + 64 * j]; }
#pragma unroll
        for (int j = 0; j < 16; ++j) { s0 += (v0[j].x * v0[j].x + v0[j].y * v0[j].y) + (v0[j].z * v0[j].z + v0[j].w * v0[j].w); s1 += (v1[j].x * v1[j].x + v1[j].y * v1[j].y) + (v1[j].z * v1[j].z + v1[j].w * v1[j].w); }
        const float r0 = 1.0f / sqrtf(wave_sum(s0) * (1.0f / DM) + EPS), r1 = 1.0f / sqrtf(wave_sum(s1) * (1.0f / DM) + EPS);
        v2u* o = (v2u*)(H + (size_t)row * DM) + lane;
#pragma unroll
        for (int jb = 0; jb < 16; jb += 4) { f32x4 g4[4], sh[4], sc[4];
#pragma unroll
            for (int j = 0; j < 4; ++j) { const int c = 4 * (lane + 64 * (jb + j)); g4[j] = *(const f32x4*)(g + c); sh[j] = *(const f32x4*)(md + c); sc[j] = *(const f32x4*)(md + DM + c); }
            asm volatile("" ::: "memory"); __builtin_amdgcn_sched_barrier(0);
#pragma unroll
            for (int j = 0; j < 4; ++j) { const f32x4 gm = g4[j] * (sc[j] + 1.0f); const f32x4 y0 = v0[jb + j] * r0 * gm + sh[j], y1 = v1[jb + j] * r1 * gm + sh[j];
                v2u w; w.x = pk2(y0.x, y0.y); w.y = pk2(y0.z, y0.w); o[64 * (jb + j)] = w; w.x = pk2(y1.x, y1.y); w.y = pk2(y1.z, y1.w); o[DM / 4 + 64 * (jb + j)] = w; }
            asm volatile("" ::: "memory"); }
    }
    for (int row = (row_lo > MP ? row_lo : MP) + gw; row < row_hi; row += NGW) {
        const int bi = NBATCH + row - MP; const float* md = modL + (size_t)bi * 3 * DM;
        const float* xrow = L == 0 ? A->in[1] + (size_t)(row - MP) * DM : A->out + (size_t)row * DM;
        const f32x4* xr = (const f32x4*)xrow + lane; f32x4 v[16]; float s = 0.f;
#pragma unroll
        for (int j = 0; j < 16; ++j) { v[j] = xr[64 * j]; s += (v[j].x * v[j].x + v[j].y * v[j].y) + (v[j].z * v[j].z + v[j].w * v[j].w); }
        const float rstd = 1.0f / sqrtf(wave_sum(s) * (1.0f / DM) + EPS);
        v2u* o = (v2u*)(H + (size_t)row * DM) + lane;
#pragma unroll
        for (int jb = 0; jb < 16; jb += 8) { f32x4 g4[8], sh[8], sc[8];
#pragma unroll
            for (int j = 0; j < 8; ++j) { const int c = 4 * (lane + 64 * (jb + j)); g4[j] = *(const f32x4*)(g + c); sh[j] = *(const f32x4*)(md + c); sc[j] = *(const f32x4*)(md + DM + c); }
            asm volatile("" ::: "memory"); __builtin_amdgcn_sched_barrier(0);
#pragma unroll
            for (int j = 0; j < 8; ++j) { const f32x4 y = v[jb + j] * rstd * g4[j] * (sc[j] + 1.0f) + sh[j]; v2u w; w.x = pk2(y.x, y.y); w.y = pk2(y.z, y.w); o[64 * (jb + j)] = w; }
            asm volatile("" ::: "memory"); }
    }
}
__device__ __forceinline__ void final_phase(CArgs* A, int gw, int NGW, int lane) {
    f32x4 gf[16];
#pragma unroll
    for (int j = 0; j < 16; ++j) gf[j] = *(const f32x4*)(A->in[24] + 4 * (lane + 64 * j));
    for (int row = gw; row < MR; row += NGW) {
        f32x4* xr = (f32x4*)(A->out + (size_t)row * DM) + lane; f32x4 v[16]; float s = 0.f;
#pragma unroll
        for (int j = 0; j < 16; ++j) { v[j] = xr[64 * j]; s += (v[j].x * v[j].x + v[j].y * v[j].y) + (v[j].z * v[j].z + v[j].w * v[j].w); }
        const float rstd = 1.0f / sqrtf(wave_sum(s) * (1.0f / DM) + EPS);
#pragma unroll
        for (int j = 0; j < 16; ++j) xr[64 * j] = v[j] * rstd * gf[j];
    }
}

__device__ __forceinline__ void rope_phase(CArgs* A, int L, int gid, int NT) {
    bf16* Z = (bf16*)(A->ws + WS_Z); const float* CS = (const float*)(A->ws + WS_ROPE); const float* SN = CS + (SEQ + 1) * 64;
    for (int it = MP * 160 + gid; it < MR * 20 * 8; it += NT) {
        const int i8 = it & 7, hh = (it >> 3) % 20, row = it / 160;
        const int col = hh < NH ? ZQ + hh * HD : ZK + (hh - NH) * HD, pi = row < MP ? (row & (SEQ - 1)) : SEQ;
        bf16* p1 = Z + (size_t)row * DIN + col + 8 * i8; const v4u a = *(const v4u*)p1, b = *(const v4u*)(p1 + 64);
        const f32x4 c0 = *(const f32x4*)(CS + pi * 64 + 8 * i8), c1 = *(const f32x4*)(CS + pi * 64 + 8 * i8 + 4), s0 = *(const f32x4*)(SN + pi * 64 + 8 * i8), s1 = *(const f32x4*)(SN + pi * 64 + 8 * i8 + 4);
        float x1[8], x2[8], o1[8], o2[8];
#pragma unroll
        for (int e = 0; e < 4; ++e) { x1[2 * e] = blo(a[e]); x1[2 * e + 1] = bhi(a[e]); x2[2 * e] = blo(b[e]); x2[2 * e + 1] = bhi(b[e]); }
#pragma unroll
        for (int e = 0; e < 8; ++e) { const float c = e < 4 ? c0[e & 3] : c1[e & 3], s = e < 4 ? s0[e & 3] : s1[e & 3]; o1[e] = x1[e] * c - x2[e] * s; o2[e] = x2[e] * c + x1[e] * s; }
        v4u w1, w2;
#pragma unroll
        for (int e = 0; e < 4; ++e) { w1[e] = pk2(o1[2 * e], o1[2 * e + 1]); w2[e] = pk2(o2[2 * e], o2[2 * e + 1]); }
        *(v4u*)p1 = w1; *(v4u*)(p1 + 64) = w2;
        if (hh >= NH) { const int kvh = hh - NH; float* dst = nullptr;
            if (row < MP) { const int t = row & (SEQ - 1), b_ = row / SEQ; if (t >= SEQ - WIN) dst = A->out + O_KP + ((((size_t)L * NBATCH + b_) * WIN + (t - (SEQ - WIN))) * NKV + kvh) * HD; }
            else dst = A->out + O_KS + ((((size_t)L * SBATCH + (row - MP)) * WIN + (WIN - 1)) * NKV + kvh) * HD;
            if (dst) { *(f32x4*)(dst + 8 * i8) = (f32x4){o1[0], o1[1], o1[2], o1[3]}; *(f32x4*)(dst + 8 * i8 + 4) = (f32x4){o1[4], o1[5], o1[6], o1[7]};
                       *(f32x4*)(dst + 64 + 8 * i8) = (f32x4){o2[0], o2[1], o2[2], o2[3]}; *(f32x4*)(dst + 64 + 8 * i8 + 4) = (f32x4){o2[4], o2[5], o2[6], o2[7]}; } }
    }
    for (int it = NBATCH * WIN * 64 + gid; it < (NBATCH * WIN + SBATCH) * 64; it += NT) { const int c8 = it & 63, rr = it >> 6; int row; float* dst;
        if (rr < NBATCH * WIN) { const int b_ = rr / WIN, j = rr % WIN; row = b_ * SEQ + (SEQ - WIN) + j; dst = A->out + O_VP + (((size_t)L * NBATCH + b_) * WIN + j) * (NKV * HD); }
        else { const int bs = rr - NBATCH * WIN; row = MP + bs; dst = A->out + O_VS + (((size_t)L * SBATCH + bs) * WIN + (WIN - 1)) * (NKV * HD); }
        const v4u a = *(const v4u*)(Z + (size_t)row * DIN + ZV + 8 * c8);
        *(f32x4*)(dst + 8 * c8) = (f32x4){blo(a.x), bhi(a.x), blo(a.y), bhi(a.y)}; *(f32x4*)(dst + 8 * c8 + 4) = (f32x4){blo(a.z), bhi(a.z), blo(a.w), bhi(a.w)}; }
    constexpr int ROW4 = NKV * HD / 4;
    constexpr int NSH = 2 * SBATCH * (WIN - 1) * ROW4;
    for (int it0 = gid; it0 < NSH; it0 += 8 * NT) { f32x4 v[8];
#pragma unroll
        for (int k = 0; k < 8; ++k) { const int it = it0 + k * NT; if (it < NSH) { const int kv = it / (SBATCH * (WIN - 1) * ROW4), r = it % (SBATCH * (WIN - 1) * ROW4), c4 = r % ROW4, j = (r / ROW4) % (WIN - 1), bs = r / (ROW4 * (WIN - 1));
            v[k] = ((const f32x4*)((kv ? A->in[5] : A->in[4]) + (((size_t)L * SBATCH + bs) * WIN + j + 1) * (NKV * HD)))[c4]; } }
        asm volatile("" ::: "memory"); __builtin_amdgcn_sched_barrier(0);
#pragma unroll
        for (int k = 0; k < 8; ++k) { const int it = it0 + k * NT; if (it < NSH) { const int kv = it / (SBATCH * (WIN - 1) * ROW4), r = it % (SBATCH * (WIN - 1) * ROW4), c4 = r % ROW4, j = (r / ROW4) % (WIN - 1), bs = r / (ROW4 * (WIN - 1));
            ((f32x4*)(A->out + (kv ? O_VS : O_KS) + (((size_t)L * SBATCH + bs) * WIN + j) * (NKV * HD)))[c4] = v[k]; } }
    }
}

__device__ __forceinline__ void ssm_prompt_unit(CArgs* A, int L, int unit, LAS unsigned char* wl, int lane) {
    const int b_ = unit / NG, g = unit % NG;
    LAS float* hre = (LAS float*)wl; LAS float* him = hre + 16 * 64; LAS float* ub = him + 16 * 64; LAS float* cre = ub + 256; LAS float* cim = cre + 16 * 64;
    const size_t gp = ((size_t)L * NG + g) * PS + lane;
    const float lr = ((const float*)(A->ws + WS_LAM))[2 * gp], li = ((const float*)(A->ws + WS_LAM))[2 * gp + 1];
    float Br[GC], Bi[GC];
#pragma unroll
    for (int c = 0; c < GC; c += 4) { const f32x4 r4 = *(const f32x4*)((const float*)(A->ws + WS_BBR) + gp * GC + c), i4 = *(const f32x4*)((const float*)(A->ws + WS_BBI) + gp * GC + c);
        Br[c] = r4.x; Br[c + 1] = r4.y; Br[c + 2] = r4.z; Br[c + 3] = r4.w; Bi[c] = i4.x; Bi[c + 1] = i4.y; Bi[c + 2] = i4.z; Bi[c + 3] = i4.w; }
#pragma unroll
    for (int c = 0; c < GC; ++c) { cre[c * 64 + lane] = A->in[17][(((size_t)L * NG + g) * GC + c) * PS + lane]; cim[c * 64 + lane] = A->in[18][(((size_t)L * NG + g) * GC + c) * PS + lane]; }
    const int t_ = lane >> 2, cq = lane & 3;
    float Dk[4];
#pragma unroll
    for (int i = 0; i < 4; ++i) Dk[i] = A->in[19][(size_t)L * DSSM + g * GC + 4 * cq + i];
    const bf16* Z = (const bf16*)(A->ws + WS_Z); bf16* Y = (bf16*)(A->ws + WS_YACT);
    float hr = 0.f, hi = 0.f;
    for (int blk = 0; blk < SEQ / 16; ++blk) {
        const int m0 = b_ * SEQ + blk * 16;
        { const v2u w = *(const v2u*)(Z + (size_t)(m0 + t_) * DIN + ZU + g * GC + 4 * cq); *(LAS f32x4*)(ub + t_ * 16 + 4 * cq) = (f32x4){blo(w.x), bhi(w.x), blo(w.y), bhi(w.y)}; }
        LDS_WAIT();
#pragma unroll 4
        for (int t = 0; t < 16; ++t) { float xr = 0.f, xi = 0.f;
#pragma unroll
            for (int c = 0; c < GC; c += 4) { const f32x4 u4 = *(const LAS f32x4*)(ub + t * 16 + c);
                xr += (Br[c] * u4.x + Br[c + 1] * u4.y) + (Br[c + 2] * u4.z + Br[c + 3] * u4.w); xi += (Bi[c] * u4.x + Bi[c + 1] * u4.y) + (Bi[c + 2] * u4.z + Bi[c + 3] * u4.w); }
            const float nr = lr * hr - li * hi + xr, ni = lr * hi + li * hr + xi; hr = nr; hi = ni; hre[t * 64 + lane] = hr; him[t * 64 + lane] = hi; }
        LDS_WAIT();
        float y[4] = {0.f, 0.f, 0.f, 0.f};
#pragma unroll 4
        for (int pq = 0; pq < 16; ++pq) { const f32x4 h4r = *(const LAS f32x4*)(hre + t_ * 64 + 4 * pq), h4i = *(const LAS f32x4*)(him + t_ * 64 + 4 * pq);
#pragma unroll
            for (int i = 0; i < 4; ++i) { const f32x4 cr = *(const LAS f32x4*)(cre + (4 * cq + i) * 64 + 4 * pq), ci = *(const LAS f32x4*)(cim + (4 * cq + i) * 64 + 4 * pq);
                y[i] += ((cr.x * h4r.x + cr.y * h4r.y) + (cr.z * h4r.z + cr.w * h4r.w)) - ((ci.x * h4i.x + ci.y * h4i.y) + (ci.z * h4i.z + ci.w * h4i.w)); } }
        { const f32x4 u4 = *(const LAS f32x4*)(ub + t_ * 16 + 4 * cq);
          const float o0 = gelu_tanh(y[0] + Dk[0] * u4.x), o1 = gelu_tanh(y[1] + Dk[1] * u4.y), o2 = gelu_tanh(y[2] + Dk[2] * u4.z), o3 = gelu_tanh(y[3] + Dk[3] * u4.w);
          v2u w; w.x = pk2(o0, o1); w.y = pk2(o2, o3); *(v2u*)(Y + (size_t)(m0 + t_) * DSSM + g * GC + 4 * cq) = w; }
        LDS_WAIT();
    }
    A->out[O_HRP + (((size_t)L * NBATCH + b_) * NG + g) * PS + lane] = hr; A->out[O_HIP + (((size_t)L * NBATCH + b_) * NG + g) * PS + lane] = hi;
}
__device__ __forceinline__ void ssm_sample_unit(CArgs* A, int L, int unit, int lane) {
    const int bs = unit / NG, g = unit % NG; const size_t gp = ((size_t)L * NG + g) * PS + lane;
    const float lr = ((const float*)(A->ws + WS_LAM))[2 * gp], li = ((const float*)(A->ws + WS_LAM))[2 * gp + 1];
    const bf16* zr = (const bf16*)(A->ws + WS_Z) + (size_t)(MP + bs) * DIN + ZU + g * GC; const v4u ua = *(const v4u*)zr, ub_ = *(const v4u*)(zr + 8);
    float u[GC];
#pragma unroll
    for (int e = 0; e < 4; ++e) { u[2 * e] = blo(ua[e]); u[2 * e + 1] = bhi(ua[e]); u[8 + 2 * e] = blo(ub_[e]); u[8 + 2 * e + 1] = bhi(ub_[e]); }
    float xr = 0.f, xi = 0.f;
#pragma unroll
    for (int c = 0; c < GC; ++c) { xr += ((const float*)(A->ws + WS_BBR))[gp * GC + c] * u[c]; xi += ((const float*)(A->ws + WS_BBI))[gp * GC + c] * u[c]; }
    const size_t si = (((size_t)L * SBATCH + bs) * NG + g) * PS + lane; const float h0r = A->in[6][si], h0i = A->in[7][si];
    const float hr = lr * h0r - li * h0i + xr, hi = lr * h0i + li * h0r + xi;
    A->out[O_HRS + si] = hr; A->out[O_HIS + si] = hi;
    float mine = 0.f;
#pragma unroll
    for (int c = 0; c < GC; ++c) { const size_t ci = (((size_t)L * NG + g) * GC + c) * PS + lane; const float yv = wave_sum(A->in[17][ci] * hr - A->in[18][ci] * hi); if (lane == c) mine = yv + A->in[19][(size_t)L * DSSM + g * GC + c] * u[c]; }
    if (lane < GC) ((bf16*)(A->ws + WS_YACT))[(size_t)(MP + bs) * DSSM + g * GC + lane] = (bf16)f2bf(gelu_tanh(mine));
}

__device__ __forceinline__ void load8(const bf16* p, float (&o)[8]) { const v4u a = *(const v4u*)p;
#pragma unroll
    for (int e = 0; e < 4; ++e) { o[2 * e] = blo(a[e]); o[2 * e + 1] = bhi(a[e]); } }
__device__ __forceinline__ void load8(const float* p, float (&o)[8]) { const f32x4 a = *(const f32x4*)p, b = *(const f32x4*)(p + 4); o[0] = a.x; o[1] = a.y; o[2] = a.z; o[3] = a.w; o[4] = b.x; o[5] = b.y; o[6] = b.z; o[7] = b.w; }
__device__ __forceinline__ void load2(const bf16* p, float& a, float& b) { const unsigned w = *(const unsigned*)p; a = blo(w); b = bhi(w); }
__device__ __forceinline__ void load2(const float* p, float& a, float& b) { const float2 w = *(const float2*)p; a = w.x; b = w.y; }
template <typename KT>
__device__ __forceinline__ void attn_task(const bf16* qrow, const KT* Kself, const KT* Vself, size_t kstride, int nkeys, float sink, const bf16* gate, bf16* orow, int lane) {
    const bool v0 = lane < nkeys, v1 = lane + 64 < nkeys;
    const KT* k0 = Kself - (size_t)(v0 ? lane : 0) * kstride; const KT* k1 = Kself - (size_t)(v1 ? lane + 64 : 0) * kstride;
    float s0 = 0.f, s1 = 0.f;
#pragma unroll 4
    for (int c = 0; c < 16; ++c) { float q8[8], a8[8], b8[8]; load8(qrow + 8 * c, q8); load8(k0 + 8 * c, a8); load8(k1 + 8 * c, b8);
#pragma unroll
        for (int e = 0; e < 8; ++e) { s0 += q8[e] * a8[e]; s1 += q8[e] * b8[e]; } }
    s0 = v0 ? s0 * ATT_SCALE : -INFINITY; s1 = v1 ? s1 * ATT_SCALE : -INFINITY;
    const float m = fmaxf(wave_max(fmaxf(s0, s1)), sink);
    const float p0 = v0 ? __expf(s0 - m) : 0.f, p1 = v1 ? __expf(s1 - m) : 0.f;
    const float den = wave_sum(p0 + p1) + __expf(sink - m);
    float o0 = 0.f, o1 = 0.f;
    const KT* vp = Vself + 2 * lane;
#pragma unroll 1
    for (int i0 = 0; i0 < 128; i0 += 16) { if (i0 >= nkeys) break; float va[16], vb_[16];
#pragma unroll
        for (int j = 0; j < 16; ++j) { const int i = i0 + j; load2(vp - (size_t)(i < nkeys ? i : 0) * kstride, va[j], vb_[j]); }
#pragma unroll
        for (int j = 0; j < 16; ++j) { const int i = i0 + j; const float pi = __builtin_bit_cast(float, __builtin_amdgcn_readlane(__builtin_bit_cast(int, i0 < 64 ? p0 : p1), i & 63)); o0 += pi * va[j]; o1 += pi * vb_[j]; } }
    float ga, gb; load2(gate + 2 * lane, ga, gb);
    const float inv = 1.0f / den;
    *(unsigned*)(orow + 2 * lane) = pk2(o0 * inv * ga * sigm(ga), o1 * inv * gb * sigm(gb));
}
__device__ __forceinline__ void attn_phase(CArgs* A, int L, int gw, int NGW, int lane) {
    const bf16* Z = (const bf16*)(A->ws + WS_Z); bf16* CAT = (bf16*)(A->ws + WS_CAT);
    for (int task = gw; task < MR * NH; task += NGW) {
        const int row = task / NH, h = task % NH, kvh = h / (NH / NKV);
        const float sink = A->in[22][L * NH + h];
        const bf16* zr = Z + (size_t)row * DIN; bf16* orow = CAT + (size_t)row * DM + DSSM + h * HD;
        if (row < MP) { const int t = row & (SEQ - 1); attn_task<bf16>(zr + ZQ + h * HD, zr + ZK + kvh * HD, zr + ZV + kvh * HD, (size_t)DIN, t + 1 < WIN ? t + 1 : WIN, sink, zr + ZGA + h * HD, orow, lane); }
        else { const int bs = row - MP; const size_t wo = ((((size_t)L * SBATCH + bs) * WIN + (WIN - 1)) * NKV + kvh) * HD;
            attn_task<float>(zr + ZQ + h * HD, A->out + O_KS + wo, A->out + O_VS + wo, (size_t)(NKV * HD), WIN, sink, zr + ZGA + h * HD, orow, lane); }
    }
}
typedef float f32x16 __attribute__((ext_vector_type(16)));
typedef short s16x4 __attribute__((ext_vector_type(4)));
#define KSWZ(row, colB) ((row) * 256 + ((colB) ^ (((row) & 7) << 4)))
#define SBAR() __builtin_amdgcn_sched_barrier(0)
constexpr float ATT_THR = 4.f;
__device__ __forceinline__ int crow(int r, int hi) { return (r & 3) + 8 * (r >> 2) + 4 * hi; }
__device__ __forceinline__ unsigned cvtpk(float lo, float hi) { unsigned r; asm volatile("v_cvt_pk_bf16_f32 %0, %1, %2" : "=v"(r) : "v"(lo), "v"(hi)); return r; }
__device__ __forceinline__ void partialSM(f32x16& p0, f32x16& p1, float& m_reg, float& alpha) {
    constexpr float C = ATT_SCALE * 1.4426950408889634f;
    float pmax = p0[0];
#pragma unroll
    for (int r = 1; r < 16; ++r) pmax = fmaxf(pmax, p0[r]);
#pragma unroll
    for (int r = 0; r < 16; ++r) pmax = fmaxf(pmax, p1[r]);
    { auto rr = __builtin_amdgcn_permlane32_swap(__float_as_uint(pmax), __float_as_uint(pmax), false, false); pmax = fmaxf(__uint_as_float(rr[0]), __uint_as_float(rr[1])); }
    float mn;
    if (__builtin_expect(__all(pmax - m_reg <= ATT_THR / ATT_SCALE), 1)) { mn = m_reg; alpha = 1.f; }
    else { mn = fmaxf(m_reg, pmax); alpha = __builtin_amdgcn_exp2f((m_reg - mn) * C); m_reg = mn; }
    const float mnC = -mn * C;
#pragma unroll
    for (int r = 0; r < 16; ++r) { p0[r] = __builtin_amdgcn_exp2f(fmaf(p0[r], C, mnC)); p1[r] = __builtin_amdgcn_exp2f(fmaf(p1[r], C, mnC)); }
}
__device__ __forceinline__ void finishSM(const f32x16& p0, const f32x16& p1, float alpha, float& l_reg, bf16x8& pa0, bf16x8& pa1, bf16x8& pa2, bf16x8& pa3) {
    float ps = 0.f;
#pragma unroll
    for (int r = 0; r < 16; ++r) ps += p0[r] + p1[r];
    { auto rr = __builtin_amdgcn_permlane32_swap(__float_as_uint(ps), __float_as_uint(ps), false, false); ps = __uint_as_float(rr[0]) + __uint_as_float(rr[1]); }
    l_reg = l_reg * alpha + ps;
#define PK4(P, BASE, OUT) do { unsigned a0 = cvtpk(P[BASE + 0], P[BASE + 1]), a1 = cvtpk(P[BASE + 2], P[BASE + 3]); unsigned b0 = cvtpk(P[BASE + 4], P[BASE + 5]), b1 = cvtpk(P[BASE + 6], P[BASE + 7]); \
    auto r0 = __builtin_amdgcn_permlane32_swap(a0, b0, false, false); auto r1 = __builtin_amdgcn_permlane32_swap(a1, b1, false, false); v4u w = {r0[0], r1[0], r0[1], r1[1]}; OUT = __builtin_bit_cast(bf16x8, w); } while (0)
    PK4(p0, 0, pa0); PK4(p0, 8, pa1); PK4(p1, 0, pa2); PK4(p1, 8, pa3);
#undef PK4
}
__device__ __forceinline__ void qkt(f32x16& p0, f32x16& p1, const LAS unsigned char* Ks, const bf16x8 (&qr)[8], int r32, int hi) {
#pragma unroll
    for (int r = 0; r < 16; ++r) { p0[r] = 0.f; p1[r] = 0.f; }
#pragma unroll
    for (int d0 = 0; d0 < 8; ++d0) { const int cb = (d0 * 16 + hi * 8) * 2;
        const bf16x8 b0 = *(const LAS bf16x8*)(Ks + KSWZ(r32, cb)), b1 = *(const LAS bf16x8*)(Ks + KSWZ(32 + r32, cb));
        p0 = __builtin_amdgcn_mfma_f32_32x32x16_bf16(b0, qr[d0], p0, 0, 0, 0); p1 = __builtin_amdgcn_mfma_f32_32x32x16_bf16(b1, qr[d0], p1, 0, 0, 0); }
}
__device__ __forceinline__ int v_st(int k, int c) { const int kk = (k & ~0xC) | ((k & 4) << 1) | ((k & 8) >> 1); return ((kk >> 3) * 4 + (c >> 5)) * 512 + ((kk & 7) * 32 + (c & 31)) * 2; }
__device__ __forceinline__ int v_rd_base(int lane) { return ((lane & 3) << 3) | (((lane >> 2) & 3) << 6) | (((lane >> 4) & 1) << 5) | (((lane >> 5) & 1) << 8); }
constexpr int v_rd_off(int d0, int ks, int half) { return d0 * 512 + ks * 4096 + half * 2048; }
template <int OFF> __device__ __forceinline__ s16x4 tr_read(int vb) { s16x4 r; asm volatile("ds_read_b64_tr_b16 %0, %1 offset:%2" : "=&v"(r) : "v"(vb), "i"(OFF) : "memory"); return r; }
template <int D0> __device__ __forceinline__ void pv_one(f32x16& od, int vb, bf16x8 pa0, bf16x8 pa1, bf16x8 pa2, bf16x8 pa3) {
    const s16x4 l0 = tr_read<v_rd_off(D0, 0, 0)>(vb), h0 = tr_read<v_rd_off(D0, 0, 1)>(vb), l1 = tr_read<v_rd_off(D0, 1, 0)>(vb), h1 = tr_read<v_rd_off(D0, 1, 1)>(vb);
    const s16x4 l2 = tr_read<v_rd_off(D0, 2, 0)>(vb), h2 = tr_read<v_rd_off(D0, 2, 1)>(vb), l3 = tr_read<v_rd_off(D0, 3, 0)>(vb), h3 = tr_read<v_rd_off(D0, 3, 1)>(vb);
    asm volatile("s_waitcnt lgkmcnt(0)" ::: "memory"); SBAR();
#define PKV(L, H) (bf16x8){L[0], L[1], L[2], L[3], H[0], H[1], H[2], H[3]}
    od = __builtin_amdgcn_mfma_f32_32x32x16_bf16(pa0, PKV(l0, h0), od, 0, 0, 0); od = __builtin_amdgcn_mfma_f32_32x32x16_bf16(pa1, PKV(l1, h1), od, 0, 0, 0);
    od = __builtin_amdgcn_mfma_f32_32x32x16_bf16(pa2, PKV(l2, h2), od, 0, 0, 0); od = __builtin_amdgcn_mfma_f32_32x32x16_bf16(pa3, PKV(l3, h3), od, 0, 0, 0);
#undef PKV
}
constexpr int AL_K = 0, AL_V = 65536, AL_WS = 131072;
__device__ __forceinline__ void attn_mfma_unit(CArgs* A, int L, int u, LAS unsigned char* lds, int tid, int lane, int wave) {
    const int kvh = u & 3, qblk = (u >> 2) & 15, b_ = u >> 6, r32 = lane & 31, hi = lane >> 5;
    const bf16* Z = (const bf16*)(A->ws + WS_Z);
    const int m0 = b_ * SEQ + qblk * 128;
    const int tmin = qblk == 0 ? 2 : 0;
    __syncthreads();
#pragma unroll 1
    for (int rep = 0; rep < REP_AST; ++rep)
    {
        const int sr = tid >> 4, sc = (tid & 15) * 8, vst0 = v_st(sr, sc), vst1 = v_st(32 + sr, sc);
        v4u kreg[4][2], vreg[4][2];
#pragma unroll
        for (int kt = 0; kt < 4; ++kt) if (kt >= tmin) {
#pragma unroll
            for (int h2 = 0; h2 < 2; ++h2) { const bf16* rowp = Z + (size_t)(m0 - 128 + 64 * kt + 32 * h2 + sr) * DIN + kvh * HD + sc; kreg[kt][h2] = *(const v4u*)(rowp + ZK); vreg[kt][h2] = *(const v4u*)(rowp + ZV); } }
#pragma unroll
        for (int kt = 0; kt < 4; ++kt) if (kt >= tmin) {
            *(LAS v4u*)(lds + AL_K + kt * 16384 + KSWZ(sr, sc * 2)) = kreg[kt][0]; *(LAS v4u*)(lds + AL_K + kt * 16384 + KSWZ(32 + sr, sc * 2)) = kreg[kt][1];
            *(LAS v4u*)(lds + AL_V + kt * 16384 + vst0) = vreg[kt][0]; *(LAS v4u*)(lds + AL_V + kt * 16384 + vst1) = vreg[kt][1]; }
    }
    __syncthreads();
    const int hq = kvh * (NH / NKV) + (wave >> 1), td = 2 + (wave & 1);
    LAS float* wsl = (LAS float*)(lds + AL_WS + wave * 256); LAS float* li_l = wsl; LAS float* al_l = wsl + 32;
    const float sinkC = A->in[22][L * NH + hq] * 1.4426950408889634f;
    constexpr float C = ATT_SCALE * 1.4426950408889634f;
    const int vbase = (int)(uintptr_t)(lds + AL_V) + v_rd_base(lane);
#pragma unroll 1
    for (int sbr = 0; sbr < 2 * REP_ASB; ++sbr) { const int sb = sbr & 1;
        const int i = 2 * (wave & 1) + sb, rloc = 32 * i + r32;
        bf16x8 qr[8];
        { const bf16* qp = Z + (size_t)(m0 + rloc) * DIN + ZQ + hq * HD + hi * 8;
#pragma unroll
          for (int d0 = 0; d0 < 8; ++d0) qr[d0] = *(const bf16x8*)(qp + d0 * 16); }
        float m_reg = -1e30f, l_reg = 0.f; f32x16 o[4];
#pragma unroll
        for (int d = 0; d < 4; ++d)
#pragma unroll
            for (int r = 0; r < 16; ++r) o[d][r] = 0.f;
#pragma unroll
        for (int kk = 0; kk < 3; ++kk) { const int kt = td - kk; if (kt < tmin) break;
            f32x16 p0, p1; float alpha; bf16x8 pa0, pa1, pa2, pa3;
            qkt(p0, p1, lds + AL_K + kt * 16384, qr, r32, hi);
            if (kt != td - 1) {
                const int base = 64 * kt + 4 * hi - rloc - 1;
#pragma unroll
                for (int r = 0; r < 16; ++r) { const int kr = (r & 3) + 8 * (r >> 2);
                    p0[r] = (unsigned)(base + kr) < 128u ? p0[r] : -INFINITY; p1[r] = (unsigned)(base + kr + 32) < 128u ? p1[r] : -INFINITY; } }
            partialSM(p0, p1, m_reg, alpha);
            finishSM(p0, p1, alpha, l_reg, pa0, pa1, pa2, pa3);
            if (__any(alpha < 1.f)) { if (hi == 0) al_l[r32] = alpha; asm volatile("s_waitcnt lgkmcnt(0)" ::: "memory");
#pragma unroll
                for (int r = 0; r < 16; ++r) { const float a = al_l[crow(r, hi)];
#pragma unroll
                    for (int d = 0; d < 4; ++d) o[d][r] *= a; } }
            SBAR();
            const int vb = vbase + kt * 16384;
            pv_one<0>(o[0], vb, pa0, pa1, pa2, pa3); pv_one<1>(o[1], vb, pa0, pa1, pa2, pa3); pv_one<2>(o[2], vb, pa0, pa1, pa2, pa3); pv_one<3>(o[3], vb, pa0, pa1, pa2, pa3);
        }
        l_reg += __builtin_amdgcn_exp2f(sinkC - m_reg * C);
        if (hi == 0) li_l[r32] = l_reg; asm volatile("s_waitcnt lgkmcnt(0)" ::: "memory");
        bf16* CAT = (bf16*)(A->ws + WS_CAT);
        unsigned gv[16][4];
#pragma unroll
        for (int r = 0; r < 16; ++r) { const bf16* gp = Z + (size_t)(m0 + 32 * i + crow(r, hi)) * DIN + ZGA + hq * HD + r32;
#pragma unroll
            for (int d0 = 0; d0 < 4; ++d0) gv[r][d0] = (unsigned)gp[32 * d0]; }
        asm volatile("" ::: "memory"); __builtin_amdgcn_sched_barrier(0);
#pragma unroll
        for (int r = 0; r < 16; ++r) { const int orow = 32 * i + crow(r, hi); const float rl = __builtin_amdgcn_rcpf(li_l[crow(r, hi)]);
            bf16* op = CAT + (size_t)(m0 + orow) * DM + DSSM + hq * HD + r32;
#pragma unroll
            for (int d0 = 0; d0 < 4; ++d0) { const float g_ = __uint_as_float(gv[r][d0] << 16); op[32 * d0] = (bf16)f2bf(o[d0][r] * rl * g_ * sigm(g_)); } }
        asm volatile("s_waitcnt lgkmcnt(0)" ::: "memory");
    }
}
__device__ __forceinline__ void attn_sample(CArgs* A, int L, int st0, int nst, int lane) {
#pragma unroll 1
    for (int rep = 0; rep < REP_ATS; ++rep)
#pragma unroll 1
    for (int st = st0; st < SBATCH * NH; st += nst) { const int bs = st / NH, h = st % NH, kvh = h / (NH / NKV), row = MP + bs; const bf16* zr = (const bf16*)(A->ws + WS_Z) + (size_t)row * DIN;
        const size_t wo = ((((size_t)L * SBATCH + bs) * WIN + (WIN - 1)) * NKV + kvh) * HD;
        attn_task<float>(zr + ZQ + h * HD, A->out + O_KS + wo, A->out + O_VS + wo, (size_t)(NKV * HD), WIN, A->in[22][L * NH + h], zr + ZGA + h * HD, (bf16*)(A->ws + WS_CAT) + (size_t)row * DM + DSSM + h * HD, lane); }
}
__device__ __forceinline__ void attn_phase2(CArgs* A, int L, LAS unsigned char* lds, int tid, int lane, int wave) {
#pragma unroll 1
    for (int rep = 0; rep < REP_ATU; ++rep)
    { const int Gq = (int)gridDim.x, vcu = (Gq % 8 == 0) ? ((int)blockIdx.x % 8) * (Gq / 8) + (int)blockIdx.x / 8 : (int)blockIdx.x;
      for (int u = vcu; u < NBATCH * (SEQ / 128) * NKV; u += gridDim.x) attn_mfma_unit(A, L, u, lds, tid, lane, wave); }
    __syncthreads();
}
template <int NT, class Epi>
__device__ __forceinline__ void skinny_gemm(const bf16* act, int lda, const bf16* Wt, int K, int n0, LAS unsigned char* lds, int tid, int lane, int wave, const Epi& E) {
    const int r = lane & 15, q = lane >> 4, kw = K / NWAVES, kbeg = wave * kw;
    f32x4 acc[NT][2];
#pragma unroll
    for (int t = 0; t < NT; ++t) { acc[t][0] = (f32x4){0.f, 0.f, 0.f, 0.f}; acc[t][1] = (f32x4){0.f, 0.f, 0.f, 0.f}; }
    const bf16* ap = act + (size_t)r * lda + kbeg + 32 * q; const bf16* wp = Wt + (size_t)(n0 + r) * K + kbeg + 32 * q;
    bf16x8 bfA[2][4], afA[NT][4], bfB[2][4], afB[NT][4];
#define SK_LOAD(BF, AF, K0) do { _Pragma("unroll") for (int mt = 0; mt < 2; ++mt) _Pragma("unroll") for (int i = 0; i < 4; ++i) BF[mt][i] = *(const bf16x8*)(ap + (size_t)(16 * mt) * lda + (K0) + 8 * i); \
        _Pragma("unroll") for (int t = 0; t < NT; ++t) _Pragma("unroll") for (int i = 0; i < 4; ++i) AF[t][i] = *(const bf16x8*)(wp + (size_t)(16 * t) * K + (K0) + 8 * i); } while (0)
#define SK_COMP(BF, AF) do { _Pragma("unroll") for (int t = 0; t < NT; ++t) _Pragma("unroll") for (int i = 0; i < 4; ++i) { acc[t][0] = MFMA16(AF[t][i], BF[0][i], acc[t][0]); acc[t][1] = MFMA16(AF[t][i], BF[1][i], acc[t][1]); } } while (0)
    SK_LOAD(bfA, afA, 0); if (kw > 128) SK_LOAD(bfB, afB, 128);
    for (int k0 = 0; k0 < kw; k0 += 256) {
        SK_COMP(bfA, afA); if (k0 + 256 < kw) SK_LOAD(bfA, afA, k0 + 256);
        if (k0 + 128 < kw) { SK_COMP(bfB, afB); if (k0 + 384 < kw) SK_LOAD(bfB, afB, k0 + 384); }
    }
#undef SK_LOAD
#undef SK_COMP
    __syncthreads();
    LAS f32x4* Pp = (LAS f32x4*)lds;
#pragma unroll
    for (int t = 0; t < NT; ++t) { Pp[((wave * NT + t) * 2 + 0) * 64 + lane] = acc[t][0]; Pp[((wave * NT + t) * 2 + 1) * 64 + lane] = acc[t][1]; }
    __syncthreads();
    for (int e = tid; e < NT * 128; e += NTHR) { const int t = e >> 7, mt = (e >> 6) & 1, l = e & 63; f32x4 s = Pp[((0 * NT + t) * 2 + mt) * 64 + l];
#pragma unroll
        for (int w = 1; w < NWAVES; ++w) s += Pp[((w * NT + t) * 2 + mt) * 64 + l];
        E(16 * mt + (l & 15), n0 + 16 * t + 4 * (l >> 4), s); }
}
struct SkEpiZ { bf16* Zs;
    __device__ __forceinline__ void operator()(int m, int n, f32x4 a) const { v2u w; w.x = pk2(a.x, a.y); w.y = pk2(a.z, a.w); *(v2u*)(Zs + (size_t)m * DIN + rot_true(n)) = w; } };
struct SkEpiGlu { const bf16* Ys; const bf16* Gs; const float* bias; bf16* Cs;
    __device__ __forceinline__ void operator()(int m, int n, f32x4 a) const { const v2u y = *(const v2u*)(Ys + (size_t)m * DSSM + n), g = *(const v2u*)(Gs + (size_t)m * DIN + n); const f32x4 b = *(const f32x4*)(bias + n);
        const float y0 = blo(y.x), y1 = bhi(y.x), y2 = blo(y.y), y3 = bhi(y.y), g0 = blo(g.x), g1 = bhi(g.x), g2 = blo(g.y), g3 = bhi(g.y);
        v2u w; w.x = pk2(y0 * sigm(a.x + b.x) * g0 * sigm(g0), y1 * sigm(a.y + b.y) * g1 * sigm(g1)); w.y = pk2(y2 * sigm(a.z + b.z) * g2 * sigm(g2), y3 * sigm(a.w + b.w) * g3 * sigm(g3));
        *(v2u*)(Cs + (size_t)m * DM + n) = w; } };
struct SkEpiOut { const float* Xin; float* Xs; const float* gate;
    __device__ __forceinline__ void operator()(int m, int n, f32x4 a) const { const f32x4 x = *(const f32x4*)(Xin + (size_t)m * DM + n), gt = *(const f32x4*)(gate + (size_t)m * 3 * DM + n); *(f32x4*)(Xs + (size_t)m * DM + n) = x + gt * a; } };
#define REP_PRO 1
#define REP_NORM 1
#define REP_GIN 1
#define REP_SSM 1
#define REP_ATT 1
#define REP_GLU 1
#define REP_OUT 1
#ifndef MK_ONE_LAUNCH
#define MK_ONE_LAUNCH 1
#endif
__global__ void __launch_bounds__(NTHR, 2) fwd(Args args) {
    extern __shared__ __attribute__((aligned(16))) unsigned char lds_raw[];
    LAS unsigned char* lds = (LAS unsigned char*)lds_raw;
    const int tid0 = threadIdx.x; const int wave_s = __builtin_amdgcn_readfirstlane(tid0 >> 6);
    const int G = gridDim.x, NGW = G * NWAVES, NT = G * NTHR;
#define FRESH() int tid = wave_s * 64 + lane_id_fresh(); asm volatile("" : "+v"(tid));     const int lane = tid & 63, wave = __builtin_amdgcn_readfirstlane(tid >> 6), gw = blockIdx.x * NWAVES + wave, gid = blockIdx.x * NTHR + tid; (void)lane; (void)wave; (void)gw; (void)gid
    volatile LAS unsigned* MISC = (volatile LAS unsigned*)(lds + MISC_OFF);
    for (int u = tid0; u < (LDS_BYTES - LDSCTL_OFF) / 4; u += NTHR) ((LAS unsigned*)(lds + LDSCTL_OFF))[u] = 0u;
    __syncthreads();
    const int lo = args.ph_lo, hi = args.ph_hi;
    XcdBarrier bar; bar.bar = (unsigned*)(args.ws + WS_CTL) + CW_BAR; bar.x = 0; bar.st = nullptr;
    if (hi - lo > 1) bar = xcd_barrier_post((unsigned*)(args.ws + WS_CTL) + CW_BAR, MISC + 8);
    if (pg8::SplitOrder::short_share(G, (int)blockIdx.x) && tid0 == 0) (void)xb_add((unsigned*)(args.ws + WS_CTL) + CW_BAR2 + XB_XCNT(xb_xcc_id()), 1u);
#define IN(k) (lo <= (k) && (k) < hi)
#define SEAM(k) do { if (hi > (k) + 1) xcd_barrier(bar); } while (0)

    if (IN(0)) { FRESH(); pre_phase(kargs(), gid, NT); SEAM(0); }
    if (IN(1)) { FRESH();
#pragma unroll 1
        for (int rep = 0; rep < REP_PRO; ++rep) pro_phase(kargs(), lds, tid, lane, wave);
        SEAM(1); }
    for (int L = 0; L < DEPTH; ++L) {
        const int base = 2 + 5 * L;
        if (IN(base)) { FRESH();
#pragma unroll 1
            for (int rep = 0; rep < REP_NORM; ++rep) norm_phase(kargs(), L, 0, MR, gw, NGW, lane);
            SEAM(base); }
        if (IN(base + 1)) {
            {
                FRESH(); CArgs* B_ = kargs(); const int bx_ = (int)blockIdx.x, nsk = (G == 256) ? 128 : G, c_ = (G == 256) ? (bx_ % 8 - 4) * 32 + bx_ / 8 : bx_;
                if (pg8::SplitOrder::short_share(G, bx_)) {
                    XcdBarrier sb; sb.bar = (unsigned*)(B_->ws + WS_CTL) + CW_BAR2; sb.x = xb_xcc_id(); sb.st = MISC + 10;
                    { SkEpiZ SE{(bf16*)(B_->ws + WS_Z) + (size_t)MP * DIN};
                      if (G == 256) {
                        const int p9 = 9 * (c_ >> 1);
                        if (c_ & 1) skinny_gemm<4>((const bf16*)(B_->ws + WS_H) + (size_t)MP * DM, DM, (const bf16*)(B_->ws + WS_WIN) + (size_t)L * DIN * DM, DM, 16 * (p9 + 5), lds, tid, lane, wave, SE);
                        else        skinny_gemm<5>((const bf16*)(B_->ws + WS_H) + (size_t)MP * DM, DM, (const bf16*)(B_->ws + WS_WIN) + (size_t)L * DIN * DM, DM, 16 * p9, lds, tid, lane, wave, SE);
                      } else for (int grp = c_; grp < DIN / 48; grp += nsk)
                        skinny_gemm<3>((const bf16*)(B_->ws + WS_H) + (size_t)MP * DM, DM, (const bf16*)(B_->ws + WS_WIN) + (size_t)L * DIN * DM, DM, 48 * grp, lds, tid, lane, wave, SE); }
                    for (int t = c_; t < NG; t += nsk) ssm_prep_task(B_, L, t, lds, tid);
                    xcd_barrier_n(sb, (unsigned)nsk);
                    rope_phase(kargs(), L, c_ * NTHR + tid, nsk * NTHR);
                    for (int u = c_ * NWAVES + wave; u < SBATCH * NG; u += nsk * NWAVES) ssm_sample_unit(kargs(), L, u, lane);
                    xcd_barrier_n(sb, (unsigned)nsk);
                    { CArgs* C_ = kargs(); const int hh = nsk / 2 > 0 ? nsk / 2 : 1;
                      if (c_ < hh) attn_sample(C_, L, c_ * NWAVES + wave, hh * NWAVES, lane);
                      else { SkEpiGlu SE{(const bf16*)(C_->ws + WS_YACT) + (size_t)MP * DSSM, (const bf16*)(C_->ws + WS_Z) + (size_t)MP * DIN + ZG, C_->in[21] + (size_t)L * DSSM, (bf16*)(C_->ws + WS_CAT) + (size_t)MP * DM};
                        for (int g2 = c_ - hh; g2 < DSSM / 32; g2 += nsk - hh)
                            skinny_gemm<2>((const bf16*)(C_->ws + WS_YACT) + (size_t)MP * DSSM, DSSM, (const bf16*)(C_->ws + WS_WGLU) + (size_t)L * DSSM * DSSM, DSSM, 32 * g2, lds, tid, lane, wave, SE); } }
                    __syncthreads();
                }
            }
            { CArgs* A = kargs();
            pg8::Gemm g{(const pg8::bf16_t*)(A->ws + WS_H), (const pg8::bf16_t*)(A->ws + WS_WIN) + (size_t)L * DIN * DM, MP, DIN, DM}; pg8::SplitOrder S; S.init(MP, DIN, G, (int)blockIdx.x);
            pg8::EpiIn E{(pg8::bf16_t*)(A->ws + WS_Z), DIN, (const float*)(A->ws + WS_ROPE), (const float*)(A->ws + WS_ROPE) + (SEQ + 1) * 64, A->out + O_KP + (size_t)L * NBATCH * WIN * NKV * HD, A->out + O_VP + (size_t)L * NBATCH * WIN * NKV * HD};
#pragma unroll 1
            for (int rep = 0; rep < REP_GIN; ++rep) pg8::gemm_phase<pg8::EpiIn, pg8::SplitOrder, true, true>(lds, g, S, E, wave_s * 64 + lane_id_fresh());
            }
            SEAM(base + 1);
        }
        if (IN(base + 2)) { FRESH();
#pragma unroll 1
            for (int rep = 0; rep < REP_SSM; ++rep) ssm_mfma_phase(kargs(), L, lds, tid, lane, wave);
            SEAM(base + 2);
        }
        if (IN(base + 3)) {
            { FRESH();
#pragma unroll 1
              for (int rep = 0; rep < REP_ATT; ++rep) attn_phase2(kargs(), L, lds, tid, lane, wave); }
            { CArgs* A = kargs();
              pg8::Gemm g{(const pg8::bf16_t*)(A->ws + WS_YACT), (const pg8::bf16_t*)(A->ws + WS_WGLU) + (size_t)L * DSSM * DSSM, MP, DSSM, DSSM}; pg8::StaticOrder S; S.init(MP, DSSM, G, (int)blockIdx.x);
              pg8::EpiGlu E{(const pg8::bf16_t*)(A->ws + WS_YACT), DSSM, (const pg8::bf16_t*)(A->ws + WS_Z) + ZG, DIN, A->in[21] + (size_t)L * DSSM, (pg8::bf16_t*)(A->ws + WS_CAT), DM};
#pragma unroll 1
              for (int rep = 0; rep < REP_GLU; ++rep) pg8::gemm_phase<pg8::EpiGlu, pg8::StaticOrder, true, true>(lds, g, S, E, wave_s * 64 + lane_id_fresh()); }
            SEAM(base + 3);
        }
        if (IN(base + 4)) {
#define OUT_SAMPLE() do { FRESH(); CArgs* B_ = kargs(); SkEpiOut SE{L == 0 ? B_->in[1] : (const float*)(B_->out + (size_t)MP * DM), B_->out + (size_t)MP * DM, (const float*)(B_->ws + WS_MOD) + ((size_t)L * NB36 + NBATCH) * 3 * DM + 2 * DM}; \
                for (int grp = (int)blockIdx.x; grp < DM / 16; grp += G) \
                    skinny_gemm<1>((const bf16*)(B_->ws + WS_CAT) + (size_t)MP * DM, DM, (const bf16*)(B_->ws + WS_WOUT) + (size_t)L * DM * DM, DM, 16 * grp, lds, tid, lane, wave, SE); \
                __syncthreads(); } while (0)
            if ((int)blockIdx.x & 1) OUT_SAMPLE();
            { CArgs* A = kargs();
              pg8::Gemm g{(const pg8::bf16_t*)(A->ws + WS_CAT), (const pg8::bf16_t*)(A->ws + WS_WOUT) + (size_t)L * DM * DM, MP, DM, DM}; pg8::StaticOrder S; S.init(MP, DM, G, (int)blockIdx.x);
              pg8::EpiOut E{L == 0 ? A->in[0] : (const float*)A->out, A->out, DM, (const float*)(A->ws + WS_MOD) + (size_t)L * NB36 * 3 * DM + 2 * DM, 3 * DM, MP, MP, 11};
              pg8::gemm_phase<pg8::EpiOut, pg8::StaticOrder, true, true>(lds, g, S, E, wave_s * 64 + lane_id_fresh()); }
            if (!((int)blockIdx.x & 1)) OUT_SAMPLE();
#undef OUT_SAMPLE
            SEAM(base + 4);
        }
    }
    if (IN(NPHASE - 1)) { FRESH(); final_phase(kargs(), gw, NGW, lane); }
#undef IN
#undef SEAM
}

extern "C" void kernel_launch(void* const* d_in, const int* in_sizes, int n_in, void* d_out, int out_size, void* d_ws, size_t ws_size, hipStream_t stream) {
    static int grid = 0;
    if (grid == 0) {
        if (n_in != 25 || (size_t)out_size != O_END || ws_size < WS_END) { fprintf(stderr, "kernel_launch: unexpected shapes (n_in %d out %d ws %zu); nothing launched\n", n_in, out_size, ws_size); grid = -1; return; }
        int dev = 0, cus = 0, per_cu = 0;
        if (hipGetDevice(&dev) != hipSuccess || hipDeviceGetAttribute(&cus, hipDeviceAttributeMultiprocessorCount, dev) != hipSuccess) { grid = -1; return; }
        if (hipFuncSetAttribute((const void*)fwd, hipFuncAttributeMaxDynamicSharedMemorySize, LDS_BYTES) != hipSuccess) { fprintf(stderr, "kernel_launch: hipFuncSetAttribute failed\n"); grid = -1; return; }
        if (hipOccupancyMaxActiveBlocksPerMultiprocessor(&per_cu, (const void*)fwd, NTHR, LDS_BYTES) != hipSuccess || per_cu < 1) fprintf(stderr, "kernel_launch: occupancy query says %d\n", per_cu);
        (void)hipGetLastError();
        grid = cus;
    }
    if (grid < 0) return;
    (void)hipMemsetAsync((char*)d_ws + WS_CTL, 0, CTL_ZERO_BYTES, stream);
    Args a{};
    for (int i = 0; i < 25; ++i) a.in[i] = (const float*)d_in[i];
    a.out = (float*)d_out; a.ws = (unsigned char*)d_ws;
#if MK_ONE_LAUNCH
    a.ph_lo = 0; a.ph_hi = NPHASE;
    hipLaunchKernelGGL(fwd, dim3(grid), dim3(NTHR), LDS_BYTES, stream, a);
#else
    for (int ph = 0; ph < NPHASE; ++ph) { a.ph_lo = ph; a.ph_hi = ph + 1; hipLaunchKernelGGL(fwd, dim3(grid), dim3(NTHR), LDS_BYTES, stream, a); }
#endif
}
```

```cpp
#include <hip/hip_runtime.h>
#include <cstdio>
#include <cstdint>
namespace pg8 {
#define PG8_LAS __attribute__((address_space(3)))
typedef unsigned short bf16_t;
typedef short bf16x8 __attribute__((ext_vector_type(8)));
typedef float f32x4 __attribute__((ext_vector_type(4)));
typedef unsigned u32x4 __attribute__((ext_vector_type(4)));
constexpr int BM = 256, BK = 64, HALF = 128, HTB = HALF * BK * 2  , STAGE_BYTES = 8 * HTB, NXCD = 8, WGM = 4;

__host__ __device__ __forceinline__ int lds_byte(int r, int c) { const int st = (r >> 4) * 2 + (c >> 5), rr = r & 15, cc = c & 31, ob = rr * 64 + cc * 2; return st * 1024 + (ob ^ (((ob >> 9) & 1) << 5)); }
__host__ __device__ __forceinline__ void stage_rc(int b, int& R, int& C) { const int st = b / 1024, sb = b % 1024, swz = sb ^ (((sb >> 9) & 1) << 5); R = (st >> 1) * 16 + swz / 64; C = (st & 1) * 32 + (swz % 64) / 2; }
__host__ __device__ __forceinline__ int perm32(int rho) { const int n = rho >> 4, i = rho & 15; return 8 * (i >> 2) + 4 * n + (i & 3); }

struct Unit { int pm, pn; };
struct Gemm { const bf16_t* A; const bf16_t* Bt; int M, N, K; };

struct StaticOrder {
    int nM, nN, nwg, G, c;
    __host__ __device__ void init(int M, int N, int G_, int c_) { nM = M / BM; nN = N / BM; nwg = nM * nN; G = G_; c = c_; }
    __host__ __device__ bool next(int i, Unit& u) const {
        const long L = (long)i * G + c; if (L >= nwg) return false;
        int wgid = (int)L; { const int q = nwg / NXCD, r = nwg % NXCD, xcd = wgid % NXCD, off = wgid / NXCD; wgid = (xcd < r ? xcd * (q + 1) : r * (q + 1) + (xcd - r) * q) + off; }
        const int nig = WGM * nN, gid = wgid / nig, fm = gid * WGM, gsz = (nM - fm) < WGM ? (nM - fm) : WGM;
        u.pm = fm + ((wgid % nig) % gsz); u.pn = (wgid % nig) / gsz; return true;
    }
    __device__ __forceinline__ void a_ready(const Unit&) const {}
    __device__ __forceinline__ void done(const Unit&) const {}
};

__device__ __forceinline__ unsigned cvt_pk_bf16(float lo, float hi) { unsigned r; asm volatile("v_cvt_pk_bf16_f32 %0, %1, %2" : "=v"(r) : "v"(lo), "v"(hi)); return r; }
typedef float f32x2 __attribute__((ext_vector_type(2)));
__device__ __forceinline__ float bf2f_lo(unsigned w) { return __uint_as_float(w << 16); }
__device__ __forceinline__ float bf2f_hi(unsigned w) { return __uint_as_float(w & 0xffff0000u); }
__device__ __forceinline__ float sigmoidf_(float a) { return __builtin_amdgcn_rcpf(1.0f + __expf(-a)); }
struct EpiZ {
    static constexpr bool PERM = true, AFTER_DRAIN = false;
    bf16_t* O; int ldc;
    __device__ __forceinline__ void operator()(const f32x4 (&acc)[2][2][4][2], const Unit& u, int wr, int wc, int fr, int fq) const {
        asm volatile("" : "+v"(fr), "+v"(fq));
        const int row0 = u.pm * BM + wr * 64 + fr, col0 = u.pn * BM + wc * 32 + 8 * fq;
#pragma unroll
        for (int ai = 0; ai < 2; ++ai)
#pragma unroll
            for (int m = 0; m < 4; ++m) { bf16_t* rowp = O + (size_t)(row0 + ai * HALF + m * 16) * ldc + col0;
#pragma unroll
                for (int bj = 0; bj < 2; ++bj) { const f32x4 v0 = acc[ai][bj][m][0], v1 = acc[ai][bj][m][1];
                    u32x4 w; w.x = cvt_pk_bf16(v0[0], v0[1]); w.y = cvt_pk_bf16(v0[2], v0[3]); w.z = cvt_pk_bf16(v1[0], v1[1]); w.w = cvt_pk_bf16(v1[2], v1[3]);
                    *(u32x4*)(rowp + bj * HALF) = w; } }
    }
};
struct EpiGlu {
    static constexpr bool PERM = true, AFTER_DRAIN = false;
    const bf16_t* Y; int ldy; const bf16_t* G; int ldg; const float* bias; bf16_t* O; int ldo;
    __device__ __forceinline__ void operator()(const f32x4 (&acc)[2][2][4][2], const Unit& u, int wr, int wc, int fr, int fq) const {
        asm volatile("" : "+v"(fr), "+v"(fq));
        const int row0 = u.pm * BM + wr * 64 + fr, col0 = u.pn * BM + wc * 32 + 8 * fq;
        f32x4 bv[2][2];
#pragma unroll
        for (int bj = 0; bj < 2; ++bj)
#pragma unroll
            for (int n = 0; n < 2; ++n) bv[bj][n] = *(const f32x4*)(bias + col0 + bj * HALF + 4 * n);
#pragma unroll
        for (int ai = 0; ai < 2; ++ai)
#pragma unroll
          for (int mb = 0; mb < 4; mb += 4) { u32x4 yv[4][2], gv[4][2];
#pragma unroll
            for (int m = 0; m < 4; ++m) { const size_t row = (size_t)(row0 + ai * HALF + (mb + m) * 16);
#pragma unroll
                for (int bj = 0; bj < 2; ++bj) { yv[m][bj] = *(const u32x4*)(Y + row * ldy + col0 + bj * HALF); gv[m][bj] = *(const u32x4*)(G + row * ldg + col0 + bj * HALF); } }
            asm volatile("" ::: "memory"); __builtin_amdgcn_sched_barrier(0);
#pragma unroll
            for (int m = 0; m < 4; ++m) { const size_t row = (size_t)(row0 + ai * HALF + (mb + m) * 16);
#pragma unroll
                for (int bj = 0; bj < 2; ++bj) { const int col = col0 + bj * HALF; const u32x4 y8 = yv[m][bj], g8 = gv[m][bj];
                    const f32x4 a0 = acc[ai][bj][mb + m][0] + bv[bj][0], a1 = acc[ai][bj][mb + m][1] + bv[bj][1];
                    float o[8];
#pragma unroll
                    for (int e = 0; e < 8; ++e) { const unsigned yw = y8[e >> 1], gw = g8[e >> 1];
                        const float yy = (e & 1) ? bf2f_hi(yw) : bf2f_lo(yw), gg = (e & 1) ? bf2f_hi(gw) : bf2f_lo(gw), a = e < 4 ? a0[e & 3] : a1[e & 3];
                        o[e] = yy * gg * __builtin_amdgcn_rcpf((1.0f + __expf(-a)) * (1.0f + __expf(-gg))); }
                    u32x4 w; w.x = cvt_pk_bf16(o[0], o[1]); w.y = cvt_pk_bf16(o[2], o[3]); w.z = cvt_pk_bf16(o[4], o[5]); w.w = cvt_pk_bf16(o[6], o[7]);
                    *(u32x4*)(O + row * ldo + col) = w; } }
            asm volatile("" ::: "memory"); }
    }
};
struct EpiOut {
    static constexpr bool PERM = false, AFTER_DRAIN = false;
    const float* Xin; float* X; int ldx; const float* gate; int gstride; int mrows; int mprompt; int seq_shift;
    __device__ __forceinline__ void operator()(const f32x4 (&acc)[2][2][4][2], const Unit& u, int wr, int wc, int fr, int fq) const {
        asm volatile("" : "+v"(fr), "+v"(fq));
        const int row0 = u.pm * BM + wr * 64 + fr, col0 = u.pn * BM + wc * 32 + 4 * fq;
        const int bi = (u.pm * BM) >> seq_shift;
        const float* gp = gate + (size_t)bi * gstride + col0;
        f32x4 gt[2][2];
#pragma unroll
        for (int bj = 0; bj < 2; ++bj)
#pragma unroll
            for (int n = 0; n < 2; ++n) gt[bj][n] = *(const f32x4*)(gp + bj * HALF + n * 16);
#pragma unroll
        for (int ai = 0; ai < 2; ++ai)
#pragma unroll
          for (int mb = 0; mb < 4; mb += 2) { f32x4 xv[2][2][2];
#pragma unroll
            for (int m = 0; m < 2; ++m) { const float* xi = Xin + (size_t)(row0 + ai * HALF + (mb + m) * 16) * ldx + col0;
#pragma unroll
                for (int bj = 0; bj < 2; ++bj)
#pragma unroll
                    for (int n = 0; n < 2; ++n) xv[m][bj][n] = *(const f32x4*)(xi + bj * HALF + n * 16); }
            asm volatile("" ::: "memory"); __builtin_amdgcn_sched_barrier(0);
#pragma unroll
            for (int m = 0; m < 2; ++m) { float* xp = X + (size_t)(row0 + ai * HALF + (mb + m) * 16) * ldx + col0;
#pragma unroll
                for (int bj = 0; bj < 2; ++bj)
#pragma unroll
                    for (int n = 0; n < 2; ++n) *(f32x4*)(xp + bj * HALF + n * 16) = xv[m][bj][n] + gt[bj][n] * acc[ai][bj][mb + m][n]; }
            asm volatile("" ::: "memory"); }
    }
};
struct EpiOutB {
    static constexpr bool PERM = true, AFTER_DRAIN = false;
    const float* Xin32; const bf16_t* Xin16; bf16_t* X; int ldx; const float* gate; int gstride; int seq_shift;
    __device__ __forceinline__ void operator()(const f32x4 (&acc)[2][2][4][2], const Unit& u, int wr, int wc, int fr, int fq) const {
        asm volatile("" : "+v"(fr), "+v"(fq));
        const int row0 = u.pm * BM + wr * 64 + fr, col0 = u.pn * BM + wc * 32 + 8 * fq;
        const int bi = (u.pm * BM) >> seq_shift;
        const float* gp = gate + (size_t)bi * gstride + col0;
        f32x4 gt[2][2];
#pragma unroll
        for (int bj = 0; bj < 2; ++bj)
#pragma unroll
            for (int n = 0; n < 2; ++n) gt[bj][n] = *(const f32x4*)(gp + bj * HALF + 4 * n);
        if (!Xin32) {
            u32x4 xb[2][4][2];
#pragma unroll
            for (int ai = 0; ai < 2; ++ai)
#pragma unroll
                for (int m = 0; m < 4; ++m)
#pragma unroll
                    for (int bj = 0; bj < 2; ++bj) xb[ai][m][bj] = *(const u32x4*)(Xin16 + (size_t)(row0 + ai * HALF + m * 16) * ldx + col0 + bj * HALF);
            asm volatile("" ::: "memory"); __builtin_amdgcn_sched_barrier(0);
#pragma unroll
            for (int ai = 0; ai < 2; ++ai)
#pragma unroll
                for (int m = 0; m < 4; ++m) { bf16_t* xp = X + (size_t)(row0 + ai * HALF + m * 16) * ldx + col0;
#pragma unroll
                    for (int bj = 0; bj < 2; ++bj) { const u32x4 w0 = xb[ai][m][bj];
                        const f32x4 x0 = (f32x4){bf2f_lo(w0.x), bf2f_hi(w0.x), bf2f_lo(w0.y), bf2f_hi(w0.y)}, x1 = (f32x4){bf2f_lo(w0.z), bf2f_hi(w0.z), bf2f_lo(w0.w), bf2f_hi(w0.w)};
                        const f32x4 o0 = x0 + gt[bj][0] * acc[ai][bj][m][0], o1 = x1 + gt[bj][1] * acc[ai][bj][m][1];
                        u32x4 w; w.x = cvt_pk_bf16(o0[0], o0[1]); w.y = cvt_pk_bf16(o0[2], o0[3]); w.z = cvt_pk_bf16(o1[0], o1[1]); w.w = cvt_pk_bf16(o1[2], o1[3]); *(u32x4*)(xp + bj * HALF) = w; } }
            return;
        }
#pragma unroll
        for (int ai = 0; ai < 2; ++ai)
#pragma unroll
          for (int mb = 0; mb < 4; mb += 2) { f32x4 xv[2][2][2];
            if (Xin32) {
#pragma unroll
                for (int m = 0; m < 2; ++m) { const float* xi = Xin32 + (size_t)(row0 + ai * HALF + (mb + m) * 16) * ldx + col0;
#pragma unroll
                    for (int bj = 0; bj < 2; ++bj)
#pragma unroll
                        for (int n = 0; n < 2; ++n) xv[m][bj][n] = *(const f32x4*)(xi + bj * HALF + 4 * n); }
                asm volatile("" ::: "memory"); __builtin_amdgcn_sched_barrier(0);
            } else { u32x4 xb[2][2];
#pragma unroll
                for (int m = 0; m < 2; ++m) { const bf16_t* xi = Xin16 + (size_t)(row0 + ai * HALF + (mb + m) * 16) * ldx + col0;
#pragma unroll
                    for (int bj = 0; bj < 2; ++bj) xb[m][bj] = *(const u32x4*)(xi + bj * HALF); }
                asm volatile("" ::: "memory"); __builtin_amdgcn_sched_barrier(0);
#pragma unroll
                for (int m = 0; m < 2; ++m)
#pragma unroll
                    for (int bj = 0; bj < 2; ++bj) { const u32x4 w = xb[m][bj]; xv[m][bj][0] = (f32x4){bf2f_lo(w.x), bf2f_hi(w.x), bf2f_lo(w.y), bf2f_hi(w.y)}; xv[m][bj][1] = (f32x4){bf2f_lo(w.z), bf2f_hi(w.z), bf2f_lo(w.w), bf2f_hi(w.w)}; } }
#pragma unroll
            for (int m = 0; m < 2; ++m) { bf16_t* xp = X + (size_t)(row0 + ai * HALF + (mb + m) * 16) * ldx + col0;
#pragma unroll
                for (int bj = 0; bj < 2; ++bj) { const f32x4 o0 = xv[m][bj][0] + gt[bj][0] * acc[ai][bj][mb + m][0], o1 = xv[m][bj][1] + gt[bj][1] * acc[ai][bj][mb + m][1];
                    u32x4 w; w.x = cvt_pk_bf16(o0[0], o0[1]); w.y = cvt_pk_bf16(o0[2], o0[3]); w.z = cvt_pk_bf16(o1[0], o1[1]); w.w = cvt_pk_bf16(o1[2], o1[3]); *(u32x4*)(xp + bj * HALF) = w; } }
            asm volatile("" ::: "memory"); }
    }
};
struct EpiIn {
    static constexpr bool PERM = true, AFTER_DRAIN = false;
    bf16_t* O; int ldc; const float* CS; const float* SN; float* KW; float* VW; bf16_t* U; int mrows;
    __device__ __forceinline__ void operator()(const f32x4 (&acc)[2][2][4][2], const Unit& u, int wr, int wc, int fr, int fq) const {
        asm volatile("" : "+v"(fr), "+v"(fq));
        const int row0 = u.pm * BM + wr * 64 + fr, col0 = u.pn * BM + wc * 32 + 8 * fq;
        const bool is_rot = u.pn >= 16 && u.pn < 26, is_k = u.pn >= 24 && u.pn < 26, is_v = u.pn >= 26 && u.pn < 28;
        const int gi = 4 * wc + fq;
#pragma unroll
        for (int ai = 0; ai < 2; ++ai) {
          f32x4 cc[1][4], ss[1][4];
          if (is_rot) {
#pragma unroll
                for (int m = 0; m < 4; ++m) { const int t = (row0 + ai * HALF + m * 16) & 2047; cc[0][m] = *(const f32x4*)(CS + t * 64 + 4 * gi); ss[0][m] = *(const f32x4*)(SN + t * 64 + 4 * gi); }
            asm volatile("" ::: "memory"); __builtin_amdgcn_sched_barrier(0); }
#pragma unroll
            for (int m = 0; m < 4; ++m) { const int row = row0 + ai * HALF + m * 16, t = row & 2047, b_ = row >> 11; bf16_t* rowp = O + (size_t)row * ldc;
                if (is_rot) { const f32x4 c4 = cc[0][m], s4 = ss[0][m];
#pragma unroll
                    for (int bj = 0; bj < 2; ++bj) { const f32x4 x1 = acc[ai][bj][m][0], x2 = acc[ai][bj][m][1]; const f32x4 o1 = x1 * c4 - x2 * s4, o2 = x2 * c4 + x1 * s4;
                        const int hb = u.pn * BM + bj * HALF; typedef unsigned u32x2_ __attribute__((ext_vector_type(2)));
                        u32x2_ w1, w2; w1.x = cvt_pk_bf16(o1[0], o1[1]); w1.y = cvt_pk_bf16(o1[2], o1[3]); w2.x = cvt_pk_bf16(o2[0], o2[1]); w2.y = cvt_pk_bf16(o2[2], o2[3]);
                        *(u32x2_*)(rowp + hb + 4 * gi) = w1; *(u32x2_*)(rowp + hb + 64 + 4 * gi) = w2;
                        if (is_k && t >= 2048 - 128) { float* kp = KW + (((size_t)b_ * 128 + (t - (2048 - 128))) * 4 + ((u.pn - 24) * 2 + bj)) * 128; *(f32x4*)(kp + 4 * gi) = o1; *(f32x4*)(kp + 64 + 4 * gi) = o2; } }
                } else {
#pragma unroll
                    for (int bj = 0; bj < 2; ++bj) { const f32x4 v0 = acc[ai][bj][m][0], v1 = acc[ai][bj][m][1];
                        u32x4 w; w.x = cvt_pk_bf16(v0[0], v0[1]); w.y = cvt_pk_bf16(v0[2], v0[3]); w.z = cvt_pk_bf16(v1[0], v1[1]); w.w = cvt_pk_bf16(v1[2], v1[3]);
                        if (u.pn < 8) { const int col = col0 + bj * HALF; *(u32x4*)(U + ((size_t)(col >> 4) * mrows + row) * 16 + (col & 15)) = w; }
                        else *(u32x4*)(rowp + col0 + bj * HALF) = w;
                        if (is_v && t >= 2048 - 128) { float* vp = VW + (((size_t)b_ * 128 + (t - (2048 - 128))) * 4 + ((u.pn - 26) * 2 + bj)) * 128 + wc * 32 + 8 * fq; *(f32x4*)vp = v0; *(f32x4*)(vp + 4) = v1; } } } } }
    }
};
struct SplitOrder {
    int nM, nN, nwg, G, c; bool split;
    __host__ __device__ void init(int M, int N, int G_, int c_) { nM = M / BM; nN = N / BM; nwg = nM * nN; G = G_; c = c_; split = (G_ == 256) && (nwg % NXCD == 0) && ((nwg / NXCD) % 32 == 16); }
    __host__ __device__ static bool short_share(int G_, int c_) { return G_ == 256 ? (c_ % NXCD) >= NXCD / 2 : true; }
    __host__ __device__ bool next(int i, Unit& u) const {
        int wgid;
        if (split) { const int x = c % NXCD, j = c / NXCD, q = nwg / NXCD, big = q + 16, small = q - 16, off = 32 * i + j;
            if (off >= (x < NXCD / 2 ? big : small)) return false;
            wgid = (x < NXCD / 2 ? x * big : (NXCD / 2) * big + (x - NXCD / 2) * small) + off;
        } else { const long L = (long)i * G + c; if (L >= nwg) return false;
            wgid = (int)L; { const int q = nwg / NXCD, r = nwg % NXCD, xcd = wgid % NXCD, off = wgid / NXCD; wgid = (xcd < r ? xcd * (q + 1) : r * (q + 1) + (xcd - r) * q) + off; } }
        const int nig = WGM * nN, gid = wgid / nig, fm = gid * WGM, gsz = (nM - fm) < WGM ? (nM - fm) : WGM;
        u.pm = fm + ((wgid % nig) % gsz); u.pn = (wgid % nig) / gsz; return true;
    }
    __device__ __forceinline__ void a_ready(const Unit&) const {}
    __device__ __forceinline__ void done(const Unit&) const {}
};
template <class Epi, class Sched, bool ALIGN_EPI = false, bool SP2 = false>
__device__ __forceinline__ void gemm_phase(PG8_LAS unsigned char* lds, const Gemm g, const Sched& S, const Epi& E, int tid_in) {
    int tid_ = tid_in; asm volatile("" : "+v"(tid_));
    const int tid = tid_, wid = __builtin_amdgcn_readfirstlane(tid >> 6), lane = tid & 63, wr = wid >> 2, wc = wid & 3, fr = lane & 15, fq = lane >> 4;
    const int K = g.K, nt = K / BK;
    unsigned voffA[2], voffB[2];
#pragma unroll
    for (int i = 0; i < 2; ++i) { int R, C; stage_rc(tid * 16 + i * 8192, R, C); const int Rb = Epi::PERM ? ((R & ~31) + perm32(R & 31)) : R;
        voffA[i] = (unsigned)(R * K + C) * 2u; voffB[i] = (unsigned)(Rb * K + C) * 2u; }
    const size_t kstep = (size_t)(BK * 2);
    const size_t hstep = (size_t)HALF * K * 2;
    const size_t tstep = 2 * hstep;
    const unsigned ldsw = (unsigned)wid * 1024u;
    const int aoff = lds_byte(wr * 64 + fr, fq * 8), boff = lds_byte(wc * 32 + fr, fq * 8);
#define PG8_SA(b, h) (((b) * 2 + (h)) * HTB)
#define PG8_SB(b, h) ((4 + (b) * 2 + (h)) * HTB)
#define PG8_STAGE(bufoff, gbase, voff) do { _Pragma("unroll") for (int _i = 0; _i < 2; ++_i) \
        __builtin_amdgcn_global_load_lds((const unsigned*)((const char*)(gbase) + (voff)[_i]), (PG8_LAS unsigned*)(lds + (bufoff) + ldsw + _i * 8192), 16, 0, 0); } while (0)
#define PG8_LDA(dst, b, h) do { _Pragma("unroll") for (int m = 0; m < 4; ++m) _Pragma("unroll") for (int k = 0; k < 2; ++k) dst[m][k] = *(const PG8_LAS bf16x8*)(lds + PG8_SA(b, h) + aoff + m * 2048 + k * 1024); } while (0)
#define PG8_LDB(dst, b, h) do { _Pragma("unroll") for (int n = 0; n < 2; ++n) _Pragma("unroll") for (int k = 0; k < 2; ++k) dst[n][k] = *(const PG8_LAS bf16x8*)(lds + PG8_SB(b, h) + boff + n * 2048 + k * 1024); } while (0)
#define PG8_MMA(ai, bj, At, Bt) do { __builtin_amdgcn_s_setprio(1); _Pragma("unroll") for (int m = 0; m < 4; ++m) _Pragma("unroll") for (int n = 0; n < 2; ++n) _Pragma("unroll") for (int k = 0; k < 2; ++k) \
        acc[ai][bj][m][n] = __builtin_amdgcn_mfma_f32_16x16x32_bf16(Bt[n][k], At[m][k], acc[ai][bj][m][n], 0, 0, 0); __builtin_amdgcn_s_setprio(0); } while (0)
#define PG8_WAIT_V(n) asm volatile("s_waitcnt vmcnt(" #n ")" ::: "memory")
#define PG8_WAIT_L(n) asm volatile("s_waitcnt lgkmcnt(" #n ")" ::: "memory")
#define PG8_BAR __builtin_amdgcn_s_barrier()
#define PG8_SCHED __builtin_amdgcn_sched_barrier(0)
    Unit cur, nxt; int ui = 0;
    if (!S.next(0, cur)) return;
    f32x4 acc[2][2][4][2];
#pragma unroll
    for (int a = 0; a < 2; ++a)
#pragma unroll
        for (int b = 0; b < 2; ++b)
#pragma unroll
            for (int m = 0; m < 4; ++m)
#pragma unroll
                for (int n = 0; n < 2; ++n) acc[a][b][m][n] = (f32x4){0.f, 0.f, 0.f, 0.f};
    bf16x8 At[4][2], B0[2][2], B1[2][2];
    const char* cA = (const char*)g.A + (size_t)cur.pm * tstep; const char* cB = (const char*)g.Bt + (size_t)cur.pn * tstep;
    S.a_ready(cur);
    if constexpr (SP2) {
        PG8_STAGE(PG8_SB(0, 0), cB, voffB); PG8_STAGE(PG8_SB(0, 1), cB + hstep, voffB); PG8_STAGE(PG8_SA(0, 0), cA, voffA); PG8_STAGE(PG8_SA(0, 1), cA + hstep, voffA);
        if (wr == 1) PG8_BAR;
        PG8_WAIT_V(2); PG8_BAR;
        PG8_STAGE(PG8_SB(1, 0), cB + kstep, voffB); PG8_STAGE(PG8_SA(1, 0), cA + kstep, voffA); PG8_STAGE(PG8_SB(1, 1), cB + hstep + kstep, voffB);
        PG8_WAIT_V(6); PG8_BAR;
    } else {
        PG8_STAGE(PG8_SB(0, 0), cB, voffB); PG8_STAGE(PG8_SA(0, 0), cA, voffA); PG8_STAGE(PG8_SB(0, 1), cB + hstep, voffB); PG8_STAGE(PG8_SA(0, 1), cA + hstep, voffA);
        if (wr == 1) PG8_BAR;
        PG8_WAIT_V(4); PG8_BAR;
        PG8_STAGE(PG8_SB(1, 0), cB + kstep, voffB); PG8_STAGE(PG8_SA(1, 0), cA + kstep, voffA); PG8_STAGE(PG8_SB(1, 1), cB + hstep + kstep, voffB);
        PG8_WAIT_V(6); PG8_BAR;
    }
    for (;;) {
        const bool has_next = S.next(ui + 1, nxt);
        const char* nA = has_next ? (const char*)g.A + (size_t)nxt.pm * tstep : cA; const char* nB = has_next ? (const char*)g.Bt + (size_t)nxt.pn * tstep : cB;
        for (int t = 0; t < nt; t += 2) {
            const bool last = (t == nt - 2);
            const char* a1 = cA + (size_t)(t + 1) * kstep;
            const char* a2 = last ? nA : cA + (size_t)(t + 2) * kstep; const char* b2 = last ? nB : cB + (size_t)(t + 2) * kstep;
            const char* a3 = a2 + kstep; const char* b3 = b2 + kstep;
            if (last && has_next) S.a_ready(nxt);
            if constexpr (SP2) {
            PG8_LDB(B0, 0, 0); PG8_LDB(B1, 0, 1); PG8_SCHED; PG8_LDA(At, 0, 0); PG8_STAGE(PG8_SA(1, 1), a1 + hstep, voffA);
            PG8_WAIT_V(8); PG8_WAIT_L(0); PG8_BAR; PG8_MMA(0, 0, At, B0); PG8_MMA(0, 1, At, B1); PG8_BAR; PG8_SCHED;
            PG8_LDA(At, 0, 1); PG8_STAGE(PG8_SB(0, 0), b2, voffB); PG8_STAGE(PG8_SB(0, 1), b2 + hstep, voffB); PG8_STAGE(PG8_SA(0, 0), a2, voffA);
            PG8_WAIT_V(8); PG8_WAIT_L(0); PG8_BAR; PG8_MMA(1, 0, At, B0); PG8_MMA(1, 1, At, B1); PG8_BAR; PG8_SCHED;
            PG8_LDB(B0, 1, 0); PG8_LDB(B1, 1, 1); PG8_SCHED; PG8_LDA(At, 1, 0); PG8_STAGE(PG8_SA(0, 1), a2 + hstep, voffA);
            PG8_WAIT_V(8); PG8_WAIT_L(0); PG8_BAR; PG8_MMA(0, 0, At, B0); PG8_MMA(0, 1, At, B1); PG8_BAR; PG8_SCHED;
            PG8_LDA(At, 1, 1); PG8_STAGE(PG8_SB(1, 0), b3, voffB); PG8_STAGE(PG8_SB(1, 1), b3 + hstep, voffB); PG8_STAGE(PG8_SA(1, 0), a3, voffA);
            PG8_WAIT_V(8); PG8_WAIT_L(0); PG8_BAR; PG8_MMA(1, 0, At, B0); PG8_MMA(1, 1, At, B1); PG8_BAR; PG8_SCHED;
            } else {
            PG8_LDB(B0, 0, 0); PG8_SCHED; PG8_LDA(At, 0, 0); PG8_STAGE(PG8_SA(1, 1), a1 + hstep, voffA);
            PG8_WAIT_L(8); PG8_BAR; PG8_WAIT_L(0); PG8_MMA(0, 0, At, B0); PG8_BAR; PG8_SCHED;
            PG8_LDB(B1, 0, 1); PG8_STAGE(PG8_SB(0, 0), b2, voffB);
            PG8_BAR; PG8_WAIT_L(0); PG8_MMA(0, 1, At, B1); PG8_BAR;
            PG8_LDA(At, 0, 1); PG8_STAGE(PG8_SA(0, 0), a2, voffA);
            PG8_BAR; PG8_WAIT_L(0); PG8_MMA(1, 0, At, B0); PG8_BAR; PG8_SCHED;
            PG8_STAGE(PG8_SB(0, 1), b2 + hstep, voffB);
            PG8_WAIT_V(6); PG8_BAR; PG8_MMA(1, 1, At, B1); PG8_BAR;
            PG8_LDB(B0, 1, 0); PG8_SCHED; PG8_LDA(At, 1, 0); PG8_STAGE(PG8_SA(0, 1), a2 + hstep, voffA);
            PG8_WAIT_L(8); PG8_BAR; PG8_WAIT_L(0); PG8_MMA(0, 0, At, B0); PG8_BAR; PG8_SCHED;
            PG8_LDB(B1, 1, 1); PG8_STAGE(PG8_SB(1, 0), b3, voffB);
            PG8_BAR; PG8_WAIT_L(0); PG8_MMA(0, 1, At, B1); PG8_BAR;
            PG8_LDA(At, 1, 1); PG8_STAGE(PG8_SA(1, 0), a3, voffA);
            PG8_BAR; PG8_WAIT_L(0); PG8_MMA(1, 0, At, B0); PG8_BAR; PG8_SCHED;
            PG8_STAGE(PG8_SB(1, 1), b3 + hstep, voffB);
            PG8_WAIT_V(6); PG8_BAR; PG8_MMA(1, 1, At, B1); PG8_BAR;
            }
        }
        if constexpr (ALIGN_EPI) { if (wr == 0) PG8_BAR; }
        if constexpr (!Epi::AFTER_DRAIN) { E(acc, cur, wr, wc, fr, fq); S.done(cur); }
        if (!has_next) break;
#pragma unroll
        for (int a = 0; a < 2; ++a)
#pragma unroll
            for (int b = 0; b < 2; ++b)
#pragma unroll
                for (int m = 0; m < 4; ++m)
#pragma unroll
                    for (int n = 0; n < 2; ++n) acc[a][b][m][n] = (f32x4){0.f, 0.f, 0.f, 0.f};
        cur = nxt; cA = nA; cB = nB; ++ui;
        if constexpr (ALIGN_EPI) { if (wr == 1) PG8_BAR; }
    }
    PG8_WAIT_V(0);
    if constexpr (!ALIGN_EPI) { if (wr == 0) PG8_BAR; }
    PG8_BAR;
    if constexpr (Epi::AFTER_DRAIN) { E.fused(acc, cur, wr, wc, fr, fq, lds, wid, lane); S.done(cur); }
#undef PG8_SA
#undef PG8_SB
#undef PG8_STAGE
#undef PG8_LDA
#undef PG8_LDB
#undef PG8_MMA
#undef PG8_WAIT_V
#undef PG8_WAIT_L
#undef PG8_BAR
#undef PG8_SCHED
}
}
#define REP_ADA 1
#define REP_TR 1
#define REP_PREP 1
#define REP_ATS 1
#define REP_ATU 1
#define REP_AST 1
#define REP_ASB 1
constexpr int DM = 4096, NBATCH = 4, SEQ = 2048, DEPTH = 4, SBATCH = 32;
constexpr int MP = NBATCH * SEQ, MR = MP + SBATCH, MPAD = 8448;
constexpr int NG = 128, GC = 16, PS = 64, HD = 128, NH = 16, NKV = 4, WIN = 128, DSSM = 2048, DIN = 9216, NB36 = NBATCH + SBATCH;
constexpr int ZU = 0, ZG = 2048, ZQ = 4096, ZK = 6144, ZV = 6656, ZGA = 7168;
constexpr float EPS = 1e-6f, ATT_SCALE = 0.08838834764831845f;
constexpr size_t O_YP = 0, O_YS = 33554432, O_KP = 33685504, O_VP = 34734080, O_HRP = 35782656, O_HIP = 35913728, O_KS = 36044800, O_VS = 44433408, O_HRS = 52822016, O_HIS = 53870592, O_END = 54919168;
constexpr size_t MiB = 1u << 20;
constexpr size_t WS_CTL = 0, CTL_ZERO_BYTES = 1 * MiB;
constexpr size_t WS_WIN = 16 * MiB, WS_WGLU = 304 * MiB, WS_WOUT = 336 * MiB, WS_MOD = 464 * MiB, WS_H = 472 * MiB, WS_Z = 538 * MiB, WS_YACT = 688 * MiB, WS_CAT = 722 * MiB,
                 WS_LAM = 788 * MiB, WS_BBR = 789 * MiB, WS_BBI = 791 * MiB, WS_ROPE = 794 * MiB, WS_SG = 800 * MiB, WS_SF = 832 * MiB, WS_SM = 864 * MiB, WS_SPW = 872 * MiB, WS_SACT = 873 * MiB, WS_XB = 880 * MiB  , WS_U = 944 * MiB  , WS_END = 976 * MiB;
static_assert(WS_WIN + (size_t)DEPTH * DIN * DM * 2 <= WS_WGLU && WS_WGLU + (size_t)DEPTH * DSSM * DSSM * 2 <= WS_WOUT && WS_WOUT + (size_t)DEPTH * DM * DM * 2 <= WS_MOD, "ws map 1");
static_assert(WS_MOD + (size_t)DEPTH * NB36 * 3 * DM * 4 <= WS_H && WS_H + (size_t)MPAD * DM * 2 <= WS_Z && WS_Z + (size_t)MPAD * DIN * 2 <= WS_YACT && WS_YACT + (size_t)MPAD * DSSM * 2 <= WS_CAT && WS_CAT + (size_t)MPAD * DM * 2 <= WS_LAM, "ws map 2");
constexpr int CW_BAR = 4096, CW_BAR2 = 8192;
constexpr int RING_BYTES = 131072, LDS_BYTES = 163840, LDSCTL_OFF = LDS_BYTES - 1024, MISC_OFF = LDSCTL_OFF + 320;
constexpr int NWAVES = 8, NTHR = 512;
constexpr int NPHASE = 3 + 5 * DEPTH;

#define GAS __attribute__((address_space(1)))
#define LAS __attribute__((address_space(3)))
typedef unsigned short bf16;
typedef unsigned v4u __attribute__((ext_vector_type(4)));
typedef unsigned v2u __attribute__((ext_vector_type(2)));
typedef float f32x4 __attribute__((ext_vector_type(4)));
#define LDS_WAIT() asm volatile("s_waitcnt lgkmcnt(0)" ::: "memory")
#define VM_WAIT() asm volatile("s_waitcnt vmcnt(0)" ::: "memory")
__device__ __forceinline__ unsigned cvtpk_(float lo, float hi) { unsigned r; asm volatile("v_cvt_pk_bf16_f32 %0, %1, %2" : "=v"(r) : "v"(lo), "v"(hi)); return r; }
__device__ __forceinline__ unsigned f2bf(float f) { return cvtpk_(f, 0.f) & 0xffffu; }
__device__ __forceinline__ unsigned pk2(float lo, float hi) { return cvtpk_(lo, hi); }
__device__ __forceinline__ float blo(unsigned w) { return __uint_as_float(w << 16); }
__device__ __forceinline__ float bhi(unsigned w) { return __uint_as_float(w & 0xffff0000u); }
__device__ __forceinline__ float bf1(bf16 h) { return __uint_as_float((unsigned)h << 16); }
__device__ __forceinline__ float sigm(float a) { return __builtin_amdgcn_rcpf(1.0f + __expf(-a)); }
__device__ __forceinline__ float gelu_tanh(float x) { const float p = fmaf(x * x, -0.10294324f, -2.30220819f); return x * __builtin_amdgcn_rcpf(1.0f + __builtin_amdgcn_exp2f(x * p)); }
template <int X> __device__ __forceinline__ float swz_xor(float v) { return __builtin_bit_cast(float, __builtin_amdgcn_ds_swizzle(__builtin_bit_cast(int, v), (X << 10) | 0x1f)); }
__device__ __forceinline__ float wave_sum(float v) {
    v += swz_xor<1>(v); v += swz_xor<2>(v); v += swz_xor<4>(v); v += swz_xor<8>(v); v += swz_xor<16>(v);
    auto rr = __builtin_amdgcn_permlane32_swap(__float_as_uint(v), __float_as_uint(v), false, false); return __uint_as_float(rr[0]) + __uint_as_float(rr[1]);
}
__device__ __forceinline__ float wave_max(float v) {
    v = fmaxf(v, swz_xor<1>(v)); v = fmaxf(v, swz_xor<2>(v)); v = fmaxf(v, swz_xor<4>(v)); v = fmaxf(v, swz_xor<8>(v)); v = fmaxf(v, swz_xor<16>(v));
    auto rr = __builtin_amdgcn_permlane32_swap(__float_as_uint(v), __float_as_uint(v), false, false); return fmaxf(__uint_as_float(rr[0]), __uint_as_float(rr[1]));
}
__device__ __forceinline__ int lane_id_fresh() { int l; asm volatile("v_mbcnt_lo_u32_b32 %0, -1, 0\n\tv_mbcnt_hi_u32_b32 %0, -1, %0" : "=v"(l)); return l; }
__device__ __forceinline__ void sincos_d(double x, double& s, double& c) {
    const double k = __builtin_rint(x * 0.63661977236758134308);
    double r = __builtin_fma(-k, 1.5707963267948966192, x); r = __builtin_fma(-k, 6.123233995736766036e-17, r);
    const double r2 = r * r;
    double ps = -1.0 / 1307674368000.0; ps = ps * r2 + 1.0 / 6227020800.0; ps = ps * r2 - 1.0 / 39916800.0; ps = ps * r2 + 1.0 / 362880.0; ps = ps * r2 - 1.0 / 5040.0; ps = ps * r2 + 1.0 / 120.0; ps = ps * r2 - 1.0 / 6.0; ps = ps * r2 * r + r;
    double pc = -1.0 / 87178291200.0; pc = pc * r2 + 1.0 / 479001600.0; pc = pc * r2 - 1.0 / 3628800.0; pc = pc * r2 + 1.0 / 40320.0; pc = pc * r2 - 1.0 / 720.0; pc = pc * r2 + 1.0 / 24.0; pc = pc * r2 - 0.5; pc = pc * r2 + 1.0;
    const int q = (int)((long long)k & 3);
    s = (q == 0) ? ps : (q == 1) ? pc : (q == 2) ? -ps : -pc;
    c = (q == 0) ? pc : (q == 1) ? -ps : (q == 2) ? -pc : ps;
}
__device__ __forceinline__ double exp_d(double x) {
    const double k = __builtin_rint(x * 1.4426950408889634074);
    double r = __builtin_fma(-k, 0.69314718055994528623, x); r = __builtin_fma(-k, 2.3190468138462995584e-17, r);
    double p = 1.0 / 6227020800.0; p = p * r + 1.0 / 479001600.0; p = p * r + 1.0 / 39916800.0; p = p * r + 1.0 / 3628800.0; p = p * r + 1.0 / 362880.0; p = p * r + 1.0 / 40320.0; p = p * r + 1.0 / 5040.0;
    p = p * r + 1.0 / 720.0; p = p * r + 1.0 / 120.0; p = p * r + 1.0 / 24.0; p = p * r + 1.0 / 6.0; p = p * r + 0.5; p = p * r + 1.0; p = p * r + 1.0;
    const long long e = (long long)k + 1023; return p * __builtin_bit_cast(double, (unsigned long long)e << 52);
}
__device__ const double ROPE_INV[64] = { 1.0, 0.8659643233600653, 0.7498942093324559, 0.6493816315762113, 0.5623413251903491, 0.4869675251658631, 0.4216965034285822, 0.3651741272548377, 0.31622776601683794, 0.27384196342643613, 0.23713737056616552, 0.2053525026457146, 0.1778279410038923, 0.1539926526059492, 0.1333521432163324, 0.11547819846894582, 0.1, 0.08659643233600653, 0.07498942093324558, 0.06493816315762113, 0.05623413251903491, 0.04869675251658631, 0.042169650342858224, 0.03651741272548377, 0.03162277660168379, 0.027384196342643614, 0.023713737056616554, 0.02053525026457146, 0.01778279410038923, 0.01539926526059492, 0.01333521432163324, 0.011547819846894581, 0.01, 0.008659643233600654, 0.007498942093324558, 0.006493816315762113, 0.005623413251903491, 0.004869675251658631, 0.004216965034285823, 0.003651741272548377, 0.0031622776601683794, 0.0027384196342643613, 0.0023713737056616554, 0.002053525026457146, 0.0017782794100389228, 0.001539926526059492, 0.001333521432163324, 0.0011547819846894581, 0.001, 0.0008659643233600654, 0.0007498942093324559, 0.0006493816315762113, 0.0005623413251903491, 0.0004869675251658631, 0.00042169650342858224, 0.0003651741272548377, 0.00031622776601683794, 0.0002738419634264361, 0.00023713737056616554, 0.0002053525026457146, 0.00017782794100389227, 0.0001539926526059492, 0.0001333521432163324, 0.00011547819846894582 };

#define XB_TMO      128
#define XB_XCNT(j)  (256  + 64 * (j))
#define XB_XSUB(j)  (1280 + 64 * (j))
#define XB_XGEN(j)  (2304 + 64 * (j))
#define XB_TOP      3328
#define XB_TOPGEN   3392
#define XCD_BAR_WORDS 3456
#define XB_SPIN_CAP (1u << 18)

__device__ __forceinline__ unsigned xb_ld(unsigned* p)              { return __hip_atomic_load(p, __ATOMIC_RELAXED, __HIP_MEMORY_SCOPE_AGENT); }
__device__ __forceinline__ unsigned xb_add(unsigned* p, unsigned v) { return __hip_atomic_fetch_add(p, v, __ATOMIC_RELAXED, __HIP_MEMORY_SCOPE_AGENT); }
__device__ __forceinline__ unsigned xb_xcc_id() { return (unsigned)__builtin_amdgcn_s_getreg((3 << 11) | 20) & 0xFu; }
#define XB_SPIN(cond, bar) do { unsigned _sp = 0; while (cond) { __builtin_amdgcn_s_sleep(1); \
    if ((++_sp & 255u) == 0u) { if (xb_ld(&(bar)[XB_TMO])) break; if (_sp > XB_SPIN_CAP) { atomicAdd(&(bar)[XB_TMO], 1u); break; } } } } while (0)

struct XcdBarrier {
    unsigned* bar; unsigned x;
    volatile LAS unsigned* st;
};

__device__ __forceinline__ XcdBarrier xcd_barrier_post(unsigned* bar, volatile LAS unsigned* st) {
    XcdBarrier b; b.bar = bar; b.x = xb_xcc_id(); b.st = st;
    if (threadIdx.x == 0) (void)xb_add(&bar[XB_XCNT(b.x)], 1u);
    return b;
}
__device__ __forceinline__ void xcd_barrier_complete(unsigned* bar, unsigned x, unsigned G, unsigned& nloc, unsigned& nx) {
    unsigned sum, cnt, mine, sp = 0u;
    for (;;) {
        sum = 0u; cnt = 0u; mine = 0u;
#pragma unroll
        for (unsigned j = 0; j < 16; ++j) { const unsigned c = xb_ld(&bar[XB_XCNT(j)]); sum += c; cnt += (c > 0u) ? 1u : 0u; mine = (j == x) ? c : mine; }
        if (sum == G) break;
        __builtin_amdgcn_s_sleep(1);
        if ((++sp & 255u) == 0u) { if (xb_ld(&bar[XB_TMO])) break; if (sp > XB_SPIN_CAP) { atomicAdd(&bar[XB_TMO], 1u); break; } }
    }
    nloc = mine > 0u ? mine : 1u; nx = cnt > 0u ? cnt : 1u;
}

__device__ __forceinline__ void xcd_barrier_n(const XcdBarrier& b, unsigned total) {
    asm volatile("s_waitcnt vmcnt(0)" ::: "memory");
    __syncthreads();
    if (threadIdx.x == 0) {
        unsigned* bar = b.bar;
        __builtin_amdgcn_s_waitcnt(0);
        unsigned nloc = b.st[0], nx = b.st[1];
        if (nloc == 0u) { xcd_barrier_complete(bar, b.x, total, nloc, nx); b.st[0] = nloc; b.st[1] = nx; }
        const unsigned old = xb_add(&bar[XB_XSUB(b.x)], 1u);
        const unsigned gen = old / nloc;
        if (old + 1u == (gen + 1u) * nloc) {
            __builtin_amdgcn_fence(__ATOMIC_RELEASE, "agent");
            asm volatile("s_waitcnt vmcnt(0)" ::: "memory");
            const unsigned og = xb_add(&bar[XB_TOP], 1u);
            const unsigned tg = og / nx;
            if (og + 1u == (tg + 1u) * nx) xb_add(&bar[XB_TOPGEN], 1u);
            else XB_SPIN(xb_ld(&bar[XB_TOPGEN]) == tg, bar);
            __builtin_amdgcn_fence(__ATOMIC_ACQUIRE, "agent");
            xb_add(&bar[XB_XGEN(b.x)], 1u);
            asm volatile("s_waitcnt vmcnt(0)" ::: "memory");
        } else {
            XB_SPIN(xb_ld(&bar[XB_XGEN(b.x)]) == gen, bar);
            __builtin_amdgcn_fence(__ATOMIC_ACQUIRE, "agent");
            asm volatile("s_waitcnt vmcnt(0)" ::: "memory");
        }
    }
    __syncthreads();
}
__device__ __forceinline__ void xcd_barrier(const XcdBarrier& b) { xcd_barrier_n(b, gridDim.x * gridDim.y * gridDim.z); }
struct Args { const float* in[25]; float* out; unsigned char* ws; int ph_lo, ph_hi; };
typedef const Args __attribute__((address_space(4))) CArgs;
__device__ __forceinline__ CArgs* kargs() { CArgs* p = (CArgs*)__builtin_amdgcn_kernarg_segment_ptr(); asm volatile("" : "+s"(p)); return p; }
constexpr size_t SG_BYTES = 65536, SF_BYTES = 65536, SM_BYTES = 16384, SPW_BYTES = 2048;
typedef short bf16x8 __attribute__((ext_vector_type(8)));
__device__ __forceinline__ void lam_pow(double ar, double ai, double dt, double d, double& re, double& im) { const double mag = exp_d(ar * dt * d); double s, c; sincos_d(ai * dt * d, s, c); re = mag * c; im = mag * s; }

__device__ __attribute__((noinline)) void ssm_prep_task(CArgs* A, int L, int g, LAS unsigned char* lds, int tid) {
    constexpr int CST = 68;
    LAS float* LPre = (LAS float*)lds; LAS float* LPim = LPre + 17 * 64; LAS float* Bre = LPim + 17 * 64; LAS float* Bim = Bre + 1024; LAS float* Cre = Bim + 1024; LAS float* Cim = Cre + 16 * CST; LAS float* Mk = Cim + 16 * CST; LAS float* Dk = Mk + 17 * 256;
    const size_t lg = (size_t)L * NG + g;
    bf16* GA = (bf16*)(A->ws + WS_SG + lg * SG_BYTES); bf16* FA = (bf16*)(A->ws + WS_SF + lg * SF_BYTES); bf16* AM = (bf16*)(A->ws + WS_SM + lg * SM_BYTES); float* PW = (float*)(A->ws + WS_SPW + lg * SPW_BYTES);
    __syncthreads();
    const float dt_f = A->in[14][lg], a64r = A->in[12][lg * PS + (tid & 63)], a64i = A->in[13][lg * PS + (tid & 63)];
    float aer[2], aei[2], ber[2], bei[2], ce[2], ci_[2];
#pragma unroll
    for (int e = 0; e < 2; ++e) { const int p = (tid >> 4) + 32 * e, cp = tid & 15; aer[e] = A->in[12][lg * PS + p]; aei[e] = A->in[13][lg * PS + p]; ber[e] = A->in[15][(lg * PS + p) * GC + cp]; bei[e] = A->in[16][(lg * PS + p) * GC + cp];
        ce[e] = A->in[17][lg * 1024 + tid + 512 * e]; ci_[e] = A->in[18][lg * 1024 + tid + 512 * e]; }
    const float dsk = A->in[19][(size_t)L * DSSM + g * GC + (tid & 15)];
    asm volatile("" ::: "memory"); __builtin_amdgcn_sched_barrier(0);
    const double dt = exp_d((double)dt_f);
    if (tid < 64) { const int p = tid; const double ar = a64r, ai = a64i; double l1r, l1i; lam_pow(ar, ai, dt, 1.0, l1r, l1i);
        double cr = 1.0, ci = 0.0;
#pragma unroll 1
        for (int d = 0; d <= 16; ++d) { LPre[d * 64 + p] = (float)cr; LPim[d * 64 + p] = (float)ci; const double nr = cr * l1r - ci * l1i, ni = cr * l1i + ci * l1r; cr = nr; ci = ni; }
#pragma unroll
        for (int k = 0; k < 4; ++k) { double lr, li; lam_pow(ar, ai, dt, (double)(16 << k), lr, li); PW[(p * 4 + k) * 2] = (float)lr; PW[(p * 4 + k) * 2 + 1] = (float)li; } }
#pragma unroll
    for (int e = 0; e < 2; ++e) { const int p = (tid >> 4) + 32 * e, cp = tid & 15; const double ar = aer[e], ai = aei[e];
        double lr, li; lam_pow(ar, ai, dt, 1.0, lr, li); const double nr = lr - 1.0, ni = li, den = ar * ar + ai * ai, qr = (nr * ar + ni * ai) / den, qi = (ni * ar - nr * ai) / den;
        const double br = ber[e], bi = bei[e]; Bre[p * 16 + cp] = (float)(qr * br - qi * bi); Bim[p * 16 + cp] = (float)(qr * bi + qi * br);
        const int i = tid + 512 * e; Cre[(i >> 6) * CST + (i & 63)] = ce[e]; Cim[(i >> 6) * CST + (i & 63)] = ci_[e]; }
    if (tid < 256) Mk[tid] = 0.f;
    if (tid < 16) Dk[tid] = dsk;
    __syncthreads();
    for (int i = tid; i < 4096; i += NTHR) { const int p = i & 63, hq = (i >> 6) & 1, ri = (i >> 7) & 1, d = i >> 8; const float lr = LPre[d * 64 + p], li = LPim[d * 64 + p];
        const f32x4 b0 = *(const LAS f32x4*)(Bre + p * 16 + 8 * hq), b1 = *(const LAS f32x4*)(Bre + p * 16 + 8 * hq + 4), c0 = *(const LAS f32x4*)(Bim + p * 16 + 8 * hq), c1 = *(const LAS f32x4*)(Bim + p * 16 + 8 * hq + 4);
        const f32x4 w0 = ri ? lr * c0 + li * b0 : lr * b0 - li * c0, w1 = ri ? lr * c1 + li * b1 : lr * b1 - li * c1;
        const int r = 15 - d, s8 = r >> 1, q = 2 * (r & 1) + hq, rho = p + 64 * ri, ti = rho >> 4, l = (rho & 15) + 16 * q;
        v4u w; w.x = pk2(w0.x, w0.y); w.y = pk2(w0.z, w0.w); w.z = pk2(w1.x, w1.y); w.w = pk2(w1.z, w1.w); *(v4u*)(GA + (size_t)((ti * 8 + s8) * 512 + l * 8)) = w; }
    for (int i = tid; i < 4096; i += NTHR) { const int c = i & 15, q = (i >> 4) & 3, ks = (i >> 6) & 3, sx = i >> 8, p0 = 16 * ks + 4 * q;
        const f32x4 lr = *(const LAS f32x4*)(LPre + (sx + 1) * 64 + p0), li = *(const LAS f32x4*)(LPim + (sx + 1) * 64 + p0), cr = *(const LAS f32x4*)(Cre + c * CST + p0), ci = *(const LAS f32x4*)(Cim + c * CST + p0);
        const f32x4 vre = cr * lr - ci * li, vim = -(cr * li + ci * lr);
        v4u w; w.x = pk2(vre.x, vre.y); w.y = pk2(vre.z, vre.w); w.z = pk2(vim.x, vim.y); w.w = pk2(vim.z, vim.w); *(v4u*)(FA + (size_t)((sx * 4 + ks) * 512 + (c + 16 * q) * 8)) = w; }
    for (int i = tid; i < 1024; i += NTHR) { const int d = i >> 6, c = (i >> 2) & 15, cq = i & 3; f32x4 m = (f32x4){0.f, 0.f, 0.f, 0.f};
#pragma unroll 2
        for (int pq = 0; pq < PS / 4; ++pq) { const f32x4 lr = *(const LAS f32x4*)(LPre + d * 64 + 4 * pq), li = *(const LAS f32x4*)(LPim + d * 64 + 4 * pq), cr = *(const LAS f32x4*)(Cre + c * CST + 4 * pq), ci = *(const LAS f32x4*)(Cim + c * CST + 4 * pq);
            const f32x4 ar_ = cr * lr - ci * li, ai_ = cr * li + ci * lr;
#pragma unroll
            for (int e = 0; e < 4; ++e) { const f32x4 br = *(const LAS f32x4*)(Bre + (4 * pq + e) * 16 + 4 * cq), bi = *(const LAS f32x4*)(Bim + (4 * pq + e) * 16 + 4 * cq); m += ar_[e] * br - ai_[e] * bi; } }
        if (d == 0 && (c >> 2) == cq) { const float dk = Dk[c]; m.x += (c & 3) == 0 ? dk : 0.f; m.y += (c & 3) == 1 ? dk : 0.f; m.z += (c & 3) == 2 ? dk : 0.f; m.w += (c & 3) == 3 ? dk : 0.f; }
        *(LAS f32x4*)(Mk + (d + 1) * 256 + c * 16 + 4 * cq) = m; }
    __syncthreads();
    for (int i = tid; i < 16 * 64; i += NTHR) { const int d = i >> 6, l = i & 63, c = l & 15, q = l >> 4, th = q >> 1; const LAS float* mp = Mk + (d + 1 - th) * 256 + c * 16 + 8 * (q & 1);
        const f32x4 m0 = *(const LAS f32x4*)mp, m1 = *(const LAS f32x4*)(mp + 4); v4u w; w.x = pk2(m0.x, m0.y); w.y = pk2(m0.z, m0.w); w.z = pk2(m1.x, m1.y); w.w = pk2(m1.z, m1.w); *(v4u*)(AM + (size_t)i * 8) = w; }
    __syncthreads();
}

template <int CTRL> __device__ __forceinline__ float dppf(float x) { return __builtin_bit_cast(float, __builtin_amdgcn_update_dpp(0, __builtin_bit_cast(int, x), CTRL, 0xf, 0xf, true)); }
#define DPP_SHR(n) (0x110 + (n))
#define DPP_SHL(n) (0x100 + (n))
#define MFMA16(a, b, c) __builtin_amdgcn_mfma_f32_16x16x32_bf16((a), (b), (c), 0, 0, 0)
constexpr int SL_G = 0, SL_F = 65536, SL_M = 131072, SL_PW = 147456;
constexpr int SL_X = 149504;
#define SSM_BAR() do { asm volatile("s_waitcnt lgkmcnt(0)" ::: "memory"); __builtin_amdgcn_s_barrier(); asm volatile("" ::: "memory"); } while (0)
__device__ __forceinline__ void ssm_mfma_unit8(CArgs* A, int L, int g, int bp, LAS unsigned char* lds, int lane, int wave) {
    const int n = lane & 15, q = lane >> 4, bb = wave >> 2, wq = wave & 3, b_ = 2 * bp + bb;
    const bf16* zb = (const bf16*)(A->ws + WS_U) + ((size_t)g * MP + b_ * SEQ + 16 * n + (q >> 1)) * GC + 8 * (q & 1);
    bf16* yb = (bf16*)(A->ws + WS_YACT) + (size_t)(b_ * SEQ + 16 * n) * DSSM + g * GC + 4 * q;
    const LAS bf16x8* GAl = (const LAS bf16x8*)(lds + SL_G) + lane; const LAS bf16x8* FAl = (const LAS bf16x8*)(lds + SL_F) + lane; const LAS bf16x8* AMl = (const LAS bf16x8*)(lds + SL_M) + lane;
    const LAS f32x4* PWl = (const LAS f32x4*)(lds + SL_PW);
    LAS bf16x8* XH = (LAS bf16x8*)(lds + SL_X) + bb * 256 + lane;
    f32x4 cXr = (f32x4){0.f, 0.f, 0.f, 0.f}, cXi = cXr;
    bf16x8 U0[8], U1[8];
    auto ldU = [&](bf16x8 (&U)[8], int blk) {
#pragma unroll
        for (int s8 = 0; s8 < 8; ++s8) U[s8] = *(const bf16x8*)(zb + (size_t)(256 * blk + 2 * s8) * GC); };
    auto block = [&](const bf16x8 (&Uc)[8], int blk) {
        f32x4 Zr = (f32x4){0.f, 0.f, 0.f, 0.f}, Zi = Zr;
        {
            bf16x8 ga[16];
#pragma unroll
            for (int s8 = 0; s8 < 8; ++s8) { ga[s8] = GAl[(wq * 8 + s8) * 64]; ga[8 + s8] = GAl[((wq + 4) * 8 + s8) * 64]; }
            asm volatile("s_waitcnt lgkmcnt(0)" ::: "memory"); __builtin_amdgcn_sched_barrier(0);
#pragma unroll
            for (int s8 = 0; s8 < 8; ++s8) { Zr = MFMA16(ga[s8], Uc[s8], Zr); Zi = MFMA16(ga[8 + s8], Uc[s8], Zi); }
        }
        float hr[4], hi[4];
        f32x4 pw0[4], pw1[4];
#pragma unroll
        for (int r = 0; r < 4; ++r) { pw0[r] = PWl[(16 * wq + 4 * q + r) * 2]; pw1[r] = PWl[(16 * wq + 4 * q + r) * 2 + 1]; }
#pragma unroll
        for (int r = 0; r < 4; ++r) { const f32x4 w0 = pw0[r], w1 = pw1[r];
            float xr = Zr[r], xi = Zi[r];
            const float cr = dppf<DPP_SHL(15)>(cXr[r]), ci = dppf<DPP_SHL(15)>(cXi[r]);
            xr += w0.x * cr - w0.y * ci; xi += w0.x * ci + w0.y * cr;
            { const float pr = dppf<DPP_SHR(1)>(xr), pi = dppf<DPP_SHR(1)>(xi); xr += w0.x * pr - w0.y * pi; xi += w0.x * pi + w0.y * pr; }
            { const float pr = dppf<DPP_SHR(2)>(xr), pi = dppf<DPP_SHR(2)>(xi); xr += w0.z * pr - w0.w * pi; xi += w0.z * pi + w0.w * pr; }
            { const float pr = dppf<DPP_SHR(4)>(xr), pi = dppf<DPP_SHR(4)>(xi); xr += w1.x * pr - w1.y * pi; xi += w1.x * pi + w1.y * pr; }
            { const float pr = dppf<DPP_SHR(8)>(xr), pi = dppf<DPP_SHR(8)>(xi); xr += w1.z * pr - w1.w * pi; xi += w1.z * pi + w1.w * pr; }
            hr[r] = dppf<DPP_SHR(1)>(xr) + cr; hi[r] = dppf<DPP_SHR(1)>(xi) + ci; cXr[r] = xr; cXi[r] = xi; }
        SSM_BAR();
        XH[64 * wq] = __builtin_bit_cast(bf16x8, (v4u){cvtpk_(hr[0], hr[1]), cvtpk_(hr[2], hr[3]), cvtpk_(hi[0], hi[1]), cvtpk_(hi[2], hi[3])});
        SSM_BAR();
        bf16x8 Hb[4];
#pragma unroll
        for (int ks = 0; ks < 4; ++ks) Hb[ks] = XH[64 * ks];
        f32x4 Y[4];
        {   bf16x8 fa[16];
#pragma unroll
            for (int sl = 0; sl < 4; ++sl)
#pragma unroll
                for (int ks = 0; ks < 4; ++ks) fa[sl * 4 + ks] = FAl[((wq + 4 * sl) * 4 + ks) * 64];
            asm volatile("s_waitcnt lgkmcnt(0)" ::: "memory"); __builtin_amdgcn_sched_barrier(0);
#pragma unroll
            for (int sl = 0; sl < 4; ++sl) { Y[sl] = (f32x4){0.f, 0.f, 0.f, 0.f};
#pragma unroll
                for (int ks = 0; ks < 4; ++ks) Y[sl] = MFMA16(fa[sl * 4 + ks], Hb[ks], Y[sl]); } }
        {   bf16x8 am[8];
#pragma unroll
            for (int j = 0; j < 8; ++j) am[j] = AMl[(2 * j + (wq & 1)) * 64];
            asm volatile("s_waitcnt lgkmcnt(0)" ::: "memory"); __builtin_amdgcn_sched_barrier(0);
            if (wq >> 1) {
#pragma unroll
                for (int sl = 0; sl < 4; ++sl)
#pragma unroll
                    for (int s8 = 0; s8 < 8; ++s8) { constexpr int hw = 1; if (hw + 2 * sl - s8 >= 0) Y[sl] = MFMA16(am[(hw + 2 * sl - s8) & 7], Uc[s8], Y[sl]); }
            } else {
#pragma unroll
                for (int sl = 0; sl < 4; ++sl)
#pragma unroll
                    for (int s8 = 0; s8 < 8; ++s8) { constexpr int hw = 0; if (hw + 2 * sl - s8 >= 0) Y[sl] = MFMA16(am[(hw + 2 * sl - s8) & 7], Uc[s8], Y[sl]); }
            } }
#pragma unroll
        for (int sl = 0; sl < 4; ++sl) { const int s = wq + 4 * sl; v2u w; w.x = cvtpk_(gelu_tanh(Y[sl][0]), gelu_tanh(Y[sl][1])); w.y = cvtpk_(gelu_tanh(Y[sl][2]), gelu_tanh(Y[sl][3]));
            *(v2u*)(yb + (size_t)(256 * blk + s) * DSSM) = w; }
    };
    ldU(U0, 0);
    asm volatile("s_waitcnt vmcnt(0)" ::: "memory"); __syncthreads();
#pragma unroll 1
    for (int b2 = 0; b2 < SEQ / 256; b2 += 2) { ldU(U1, b2 + 1); block(U0, b2); ldU(U0, b2 + 2 < SEQ / 256 ? b2 + 2 : b2 + 1); block(U1, b2 + 1); }
    if (n == 15) { float* hr_o = A->out + O_HRP + (((size_t)L * NBATCH + b_) * NG + g) * PS; float* hi_o = A->out + O_HIP + (((size_t)L * NBATCH + b_) * NG + g) * PS;
        *(f32x4*)(hr_o + 16 * wq + 4 * q) = cXr; *(f32x4*)(hi_o + 16 * wq + 4 * q) = cXi; }
}
__device__ __forceinline__ void ssm_mfma_phase(CArgs* A, int L, LAS unsigned char* lds, int tid, int lane, int wave) {
    const int Gq = (int)gridDim.x, vcu = (Gq % 8 == 0) ? ((int)blockIdx.x % 8) * (Gq / 8) + (int)blockIdx.x / 8 : (int)blockIdx.x;
    for (int u = vcu; u < 2 * NG; u += gridDim.x) { const int g = u >> 1, bp = u & 1; const size_t lg = (size_t)L * NG + g;
        __syncthreads();
        {   const unsigned char* sG = A->ws + WS_SG + lg * SG_BYTES; const unsigned char* sF = A->ws + WS_SF + lg * SF_BYTES; const unsigned char* sM = A->ws + WS_SM + lg * SM_BYTES; const unsigned char* sP = A->ws + WS_SPW + lg * SPW_BYTES;
#pragma unroll
            for (int i = 0; i < 8; ++i) { const int o = (i * NWAVES + wave) * 1024;
                __builtin_amdgcn_global_load_lds((const unsigned*)(sG + o + lane * 16), (LAS unsigned*)(lds + SL_G + o), 16, 0, 0);
                __builtin_amdgcn_global_load_lds((const unsigned*)(sF + o + lane * 16), (LAS unsigned*)(lds + SL_F + o), 16, 0, 0); }
#pragma unroll
            for (int i = 0; i < 2; ++i) { const int o = (i * NWAVES + wave) * 1024; __builtin_amdgcn_global_load_lds((const unsigned*)(sM + o + lane * 16), (LAS unsigned*)(lds + SL_M + o), 16, 0, 0); }
            if (wave < 2) __builtin_amdgcn_global_load_lds((const unsigned*)(sP + wave * 1024 + lane * 16), (LAS unsigned*)(lds + SL_PW + wave * 1024), 16, 0, 0);
        }
        ssm_mfma_unit8(A, L, g, bp, lds, lane, wave);
    }
    __syncthreads();
}
constexpr int TR_SCR = 64 * 65 * 4;
__device__ __forceinline__ int rot_slot(int n) { if (n < ZQ || n >= ZV) return n; const int t = n & 127, hb = n & ~127; return hb + (t < 64 ? 8 * (t >> 2) + (t & 3) : 8 * ((t - 64) >> 2) + 4 + (t & 3)); }
__device__ __forceinline__ int rot_true(int s) { if (s < ZQ || s >= ZV) return s; const int t = s & 127, hb = s & ~127, gi = t >> 3, e = t & 7; return hb + (e < 4 ? 4 * gi + e : 64 + 4 * gi + (e - 4)); }
template <bool ROT>
__device__ __forceinline__ void transpose_item(const float* W, int K, int N, bf16* WT, LAS float* scr, int item, int lane) {
    const int nblk = N / 64, kb = item / nblk, nb = item % nblk, k0 = 64 * kb, n0 = 64 * nb;
    f32x4 v[16];
#pragma unroll
    for (int i = 0; i < 16; ++i) v[i] = *(const f32x4*)(W + (size_t)(k0 + 4 * i + (lane >> 4)) * N + n0 + 4 * (lane & 15));
#pragma unroll
    for (int i = 0; i < 16; ++i) { LAS float* p = scr + (4 * i + (lane >> 4)) * 65 + 4 * (lane & 15); p[0] = v[i].x; p[1] = v[i].y; p[2] = v[i].z; p[3] = v[i].w; }
    LDS_WAIT(); asm volatile("" ::: "memory");
    const int c = lane & 7;
#pragma unroll
    for (int jj = 0; jj < 8; ++jj) { const int n = (lane >> 3) + 8 * jj; const LAS float* s = scr + (8 * c) * 65 + n;
        v4u o; o.x = pk2(s[0 * 65], s[1 * 65]); o.y = pk2(s[2 * 65], s[3 * 65]); o.z = pk2(s[4 * 65], s[5 * 65]); o.w = pk2(s[6 * 65], s[7 * 65]);
        *(v4u*)(WT + (size_t)(ROT ? rot_slot(n0 + n) : n0 + n) * K + k0 + 8 * c) = o; }
    LDS_WAIT(); asm volatile("" ::: "memory");
}
__device__ __forceinline__ void pre_phase(CArgs* A, int gid, int NT) {
    bf16* S = (bf16*)(A->ws + WS_SACT);
    for (int i = gid; i < 48 * DM; i += NT) { const int r = i / DM, k = i % DM; float c = 0.f;
        if (r < NBATCH) c = A->in[2][(size_t)r * DM + k]; else if (r < NB36) c = A->in[3][(size_t)(r - NBATCH) * DM + k];
        const float s = r < NB36 ? c * sigm(c) : 0.f; const unsigned h = f2bf(s); const float rem = s - __uint_as_float(h << 16);
        S[i] = (bf16)h; S[48 * DM + i] = (bf16)f2bf(rem); }
}
#define ADA_NT 6
__device__ __forceinline__ void ada_item(CArgs* A, int item, LAS unsigned char* lds, int tid, int lane, int wave) {
    constexpr int NTL = ADA_NT, NCOL = 16 * NTL, NIT = 3 * DM / NCOL;
    const int L = item / NIT, n0 = (item % NIT) * NCOL, r = lane & 15, q = lane >> 4, kbeg = wave * (DM / NWAVES);
    const float* W = A->in[8] + (size_t)L * DM * 3 * DM + (size_t)(kbeg + 8 * q) * 3 * DM + n0 + r;
    const bf16* Sh = (const bf16*)(A->ws + WS_SACT) + (size_t)r * DM + kbeg + 8 * q; const bf16* Sl = Sh + 48 * DM;
    f32x4 acc[3][NTL];
#pragma unroll
    for (int mt = 0; mt < 3; ++mt)
#pragma unroll
        for (int nt = 0; nt < NTL; ++nt) acc[mt][nt] = (f32x4){0.f, 0.f, 0.f, 0.f};
    float wv[NTL][8];
#pragma unroll
    for (int nt = 0; nt < NTL; ++nt)
#pragma unroll
        for (int j = 0; j < 8; ++j) wv[nt][j] = W[(size_t)j * 3 * DM + 16 * nt];
    for (int ks = 0; ks < DM / NWAVES / 32; ++ks) {
        bf16x8 bh[NTL], bl[NTL];
#pragma unroll
        for (int nt = 0; nt < NTL; ++nt) { v4u h, l;
#pragma unroll
            for (int e = 0; e < 4; ++e) { const float w0 = wv[nt][2 * e], w1 = wv[nt][2 * e + 1]; const unsigned h0 = f2bf(w0), h1 = f2bf(w1);
                h[e] = h0 | (h1 << 16); l[e] = pk2(w0 - __uint_as_float(h0 << 16), w1 - __uint_as_float(h1 << 16)); }
            bh[nt] = __builtin_bit_cast(bf16x8, h); bl[nt] = __builtin_bit_cast(bf16x8, l); }
        const int kn = ks + 1 < DM / NWAVES / 32 ? ks + 1 : ks;
#pragma unroll
        for (int nt = 0; nt < NTL; ++nt)
#pragma unroll
            for (int j = 0; j < 8; ++j) wv[nt][j] = W[(size_t)(32 * kn + j) * 3 * DM + 16 * nt];
        bf16x8 ah[3], al[3];
#pragma unroll
        for (int mt = 0; mt < 3; ++mt) { ah[mt] = *(const bf16x8*)(Sh + (size_t)(16 * mt) * DM + 32 * ks); al[mt] = *(const bf16x8*)(Sl + (size_t)(16 * mt) * DM + 32 * ks); }
#pragma unroll
        for (int mt = 0; mt < 3; ++mt)
#pragma unroll
            for (int nt = 0; nt < NTL; ++nt) { acc[mt][nt] = MFMA16(ah[mt], bh[nt], acc[mt][nt]); acc[mt][nt] = MFMA16(ah[mt], bl[nt], acc[mt][nt]); acc[mt][nt] = MFMA16(al[mt], bh[nt], acc[mt][nt]); }
    }
    __syncthreads();
    LAS f32x4* Pp = (LAS f32x4*)lds;
#pragma unroll
    for (int mt = 0; mt < 3; ++mt)
#pragma unroll
        for (int nt = 0; nt < NTL; ++nt) Pp[(wave * 3 * NTL + mt * NTL + nt) * 64 + lane] = acc[mt][nt];
    __syncthreads();
    float* mod = (float*)(A->ws + WS_MOD) + (size_t)L * NB36 * 3 * DM; const float* bias = A->in[9] + (size_t)L * 3 * DM;
    for (int e = tid; e < 3 * NTL * 64; e += NTHR) { const int t = e >> 6, l = e & 63, mt = t / NTL, nt = t % NTL; f32x4 s = Pp[t * 64 + l];
#pragma unroll
        for (int w = 1; w < NWAVES; ++w) s += Pp[(w * 3 * NTL + t) * 64 + l];
        const int n = n0 + 16 * nt + (l & 15), m0 = 16 * mt + 4 * (l >> 4); const float bb = bias[n];
#pragma unroll
        for (int i = 0; i < 4; ++i) if (m0 + i < NB36) mod[(size_t)(m0 + i) * 3 * DM + n] = s[i] + bb; }
}

__device__ __forceinline__ void pro_phase(CArgs* A, LAS unsigned char* lds, int tid, int lane, int wave) {
    const int bx = blockIdx.x, G = gridDim.x;
#pragma unroll 1
    for (int rep = 0; rep < REP_ADA; ++rep)
    for (int it = bx; it < DEPTH * (3 * DM / (16 * ADA_NT)); it += G) ada_item(A, it, lds, tid, lane, wave);
    __syncthreads();
#pragma unroll 1
    for (int rep = 0; rep < REP_TR; ++rep)
    {
        LAS float* scr = (LAS float*)(lds + wave * TR_SCR);
        const int tw = bx * NWAVES + wave, NTW = G * NWAVES;
        constexpr int I_IN = (DM / 64) * (DIN / 64), I_GLU = (DSSM / 64) * (DSSM / 64), I_OUT = (DM / 64) * (DM / 64), I_L = I_IN + I_GLU + I_OUT;
        for (int it = tw; it < DEPTH * I_L; it += NTW) {
            const int L = it / I_L; int r = it % I_L;
            if (r < I_IN) { transpose_item<true>(A->in[11] + (size_t)L * DM * DIN, DM, DIN, (bf16*)(A->ws + WS_WIN) + (size_t)L * DIN * DM, scr, r, lane); continue; } r -= I_IN;
            if (r < I_GLU) { transpose_item<false>(A->in[20] + (size_t)L * DSSM * DSSM, DSSM, DSSM, (bf16*)(A->ws + WS_WGLU) + (size_t)L * DSSM * DSSM, scr, r, lane); continue; } r -= I_GLU;
            transpose_item<false>(A->in[23] + (size_t)L * DM * DM, DM, DM, (bf16*)(A->ws + WS_WOUT) + (size_t)L * DM * DM, scr, r, lane);
        }
    }
    const int gid = bx * NTHR + tid, NT = G * NTHR;
    for (int it = gid; it < DEPTH * NG * PS; it += NT) {
        const double ar = A->in[12][it], ai = A->in[13][it], dt = exp_d((double)A->in[14][it / PS]);
        const double mag = exp_d(ar * dt); double sn, cs; sincos_d(ai * dt, sn, cs);
        const double lr = mag * cs, li = mag * sn, nr = lr - 1.0, ni = li, den = ar * ar + ai * ai, qr = (nr * ar + ni * ai) / den, qi = (ni * ar - nr * ai) / den;
        ((float*)(A->ws + WS_LAM))[2 * it] = (float)lr; ((float*)(A->ws + WS_LAM))[2 * it + 1] = (float)li;
#pragma unroll
        for (int c = 0; c < GC; ++c) { const double br = A->in[15][(size_t)it * GC + c], bi = A->in[16][(size_t)it * GC + c];
            ((float*)(A->ws + WS_BBR))[(size_t)it * GC + c] = (float)(qr * br - qi * bi); ((float*)(A->ws + WS_BBI))[(size_t)it * GC + c] = (float)(qr * bi + qi * br); }
    }
    for (int it = gid; it < (SEQ + 1) * 64; it += NT) { const int pi = it >> 6, i = it & 63; const double pos = pi < SEQ ? (double)pi : 8192.0; double sn, cs; sincos_d(pos * ROPE_INV[i], sn, cs);
        ((float*)(A->ws + WS_ROPE))[it] = (float)cs; ((float*)(A->ws + WS_ROPE))[(SEQ + 1) * 64 + it] = (float)sn; }
}

__device__ __forceinline__ void norm_phase(CArgs* A, int L, int row_lo, int row_hi, int gw, int NGW, int lane) {
    bf16* H = (bf16*)(A->ws + WS_H); const float* modL = (const float*)(A->ws + WS_MOD) + (size_t)L * NB36 * 3 * DM; const float* g = A->in[10] + (size_t)L * DM;
    for (int pr = (row_lo >> 1) + gw; 2 * pr + 1 < (row_hi < MP ? row_hi : MP); pr += NGW) { const int row = 2 * pr;
        const float* md = modL + (size_t)(row / SEQ) * 3 * DM;
        f32x4 v0[8][2], v1[8][2]; float s0 = 0.f, s1 = 0.f;
        if (L == 0) { const f32x4* xr = (const f32x4*)(A->in[0] + (size_t)row * DM) + 2 * lane;
#pragma unroll
            for (int j = 0; j < 8; ++j) { v0[j][0] = xr[128 * j]; v0[j][1] = xr[128 * j + 1]; v1[j][0] = xr[DM / 4 + 128 * j]; v1[j][1] = xr[DM / 4 + 128 * j + 1]; }
        } else { const v4u* xr = (const v4u*)((const bf16*)(A->ws + WS_XB) + (size_t)row * DM) + lane; v4u b0[8], b1[8];
#pragma unroll
            for (int j = 0; j < 8; ++j) { b0[j] = xr[64 * j]; b1[j] = xr[DM / 8 + 64 * j]; }
#pragma unroll
            for (int j = 0; j < 8; ++j) { v0[j][0] = (f32x4){blo(b0[j].x), bhi(b0[j].x), blo(b0[j].y), bhi(b0[j].y)}; v0[j][1] = (f32x4){blo(b0[j].z), bhi(b0[j].z), blo(b0[j].w), bhi(b0[j].w)};
                                          v1[j][0] = (f32x4){blo(b1[j].x), bhi(b1[j].x), blo(b1[j].y), bhi(b1[j].y)}; v1[j][1] = (f32x4){blo(b1[j].z), bhi(b1[j].z), blo(b1[j].w), bhi(b1[j].w)}; } }
#pragma unroll
        for (int j = 0; j < 8; ++j)
#pragma unroll
            for (int h = 0; h < 2; ++h) { s0 += (v0[j][h].x * v0[j][h].x + v0[j][h].y * v0[j][h].y) + (v0[j][h].z * v0[j][h].z + v0[j][h].w * v0[j][h].w); s1 += (v1[j][h].x * v1[j][h].x + v1[j][h].y * v1[j][h].y) + (v1[j][h].z * v1[j][h].z + v1[j][h].w * v1[j][h].w); }
        const float r0 = 1.0f / sqrtf(wave_sum(s0) * (1.0f / DM) + EPS), r1 = 1.0f / sqrtf(wave_sum(s1) * (1.0f / DM) + EPS);
        v4u* o = (v4u*)(H + (size_t)row * DM) + lane;
#pragma unroll
        for (int jb = 0; jb < 8; jb += 2) { f32x4 g4[2][2], sh[2][2], sc[2][2];
#pragma unroll
            for (int j = 0; j < 2; ++j)
#pragma unroll
                for (int h = 0; h < 2; ++h) { const int c = 8 * (lane + 64 * (jb + j)) + 4 * h; g4[j][h] = *(const f32x4*)(g + c); sh[j][h] = *(const f32x4*)(md + c); sc[j][h] = *(const f32x4*)(md + DM + c); }
            asm volatile("" ::: "memory"); __builtin_amdgcn_sched_barrier(0);
#pragma unroll
            for (int j = 0; j < 2; ++j) { const f32x4 gm0 = g4[j][0] * (sc[j][0] + 1.0f), gm1 = g4[j][1] * (sc[j][1] + 1.0f);
                const f32x4 ya = v0[jb + j][0] * r0 * gm0 + sh[j][0], yb_ = v0[jb + j][1] * r0 * gm1 + sh[j][1], yc = v1[jb + j][0] * r1 * gm0 + sh[j][0], yd = v1[jb + j][1] * r1 * gm1 + sh[j][1];
                v4u w; w.x = cvtpk_(ya.x, ya.y); w.y = cvtpk_(ya.z, ya.w); w.z = cvtpk_(yb_.x, yb_.y); w.w = cvtpk_(yb_.z, yb_.w); o[64 * (jb + j)] = w;
                w.x = cvtpk_(yc.x, yc.y); w.y = cvtpk_(yc.z, yc.w); w.z = cvtpk_(yd.x, yd.y); w.w = cvtpk_(yd.z, yd.w); o[DM / 8 + 64 * (jb + j)] = w; }
            asm volatile("" ::: "memory"); }
    }
    for (int row = (row_lo > MP ? row_lo : MP) + gw; row < row_hi; row += NGW) {
        const int bi = NBATCH + row - MP; const float* md = modL + (size_t)bi * 3 * DM;
        const float* xrow = L == 0 ? A->in[1] + (size_t)(row - MP) * DM : A->out + (size_t)row * DM;
        const f32x4* xr = (const f32x4*)xrow + lane; f32x4 v[16]; float s = 0.f;
#pragma unroll
        for (int j = 0; j < 16; ++j) { v[j] = xr[64 * j]; s += (v[j].x * v[j].x + v[j].y * v[j].y) + (v[j].z * v[j].z + v[j].w * v[j].w); }
        const float rstd = 1.0f / sqrtf(wave_sum(s) * (1.0f / DM) + EPS);
        v2u* o = (v2u*)(H + (size_t)row * DM) + lane;
#pragma unroll
        for (int jb = 0; jb < 16; jb += 8) { f32x4 g4[8], sh[8], sc[8];
#pragma unroll
            for (int j = 0; j < 8; ++j) { const int c = 4 * (lane + 64 * (jb + j)); g4[j] = *(const f32x4*)(g + c); sh[j] = *(const f32x4*)(md + c); sc[j] = *(const f32x4*)(md + DM + c); }
            asm volatile("" ::: "memory"); __builtin_amdgcn_sched_barrier(0);
#pragma unroll
            for (int j = 0; j < 8; ++j) { const f32x4 y = v[jb + j] * rstd * g4[j] * (sc[j] + 1.0f) + sh[j]; v2u w; w.x = pk2(y.x, y.y); w.y = pk2(y.z, y.w); o[64 * (jb + j)] = w; }
            asm volatile("" ::: "memory"); }
    }
}
__device__ __forceinline__ void final_phase(CArgs* A, int gw, int NGW, int lane) {
    f32x4 gf[16];
#pragma unroll
    for (int j = 0; j < 16; ++j) gf[j] = *(const f32x4*)(A->in[24] + 4 * (lane + 64 * j));
    for (int row = gw; row < MR; row += NGW) {
        f32x4* xr = (f32x4*)(A->out + (size_t)row * DM) + lane; f32x4 v[16]; float s = 0.f;
        if (row < MP) { const v2u* xb = (const v2u*)((const bf16*)(A->ws + WS_XB) + (size_t)row * DM) + lane; v2u b[16];
#pragma unroll
            for (int j = 0; j < 16; ++j) b[j] = xb[64 * j];
#pragma unroll
            for (int j = 0; j < 16; ++j) v[j] = (f32x4){blo(b[j].x), bhi(b[j].x), blo(b[j].y), bhi(b[j].y)};
        } else {
#pragma unroll
            for (int j = 0; j < 16; ++j) v[j] = xr[64 * j]; }
#pragma unroll
        for (int j = 0; j < 16; ++j) s += (v[j].x * v[j].x + v[j].y * v[j].y) + (v[j].z * v[j].z + v[j].w * v[j].w);
        const float rstd = 1.0f / sqrtf(wave_sum(s) * (1.0f / DM) + EPS);
#pragma unroll
        for (int j = 0; j < 16; ++j) xr[64 * j] = v[j] * rstd * gf[j];
    }
}

__device__ __forceinline__ void rope_phase(CArgs* A, int L, int gid, int NT) {
    bf16* Z = (bf16*)(A->ws + WS_Z); const float* CS = (const float*)(A->ws + WS_ROPE); const float* SN = CS + (SEQ + 1) * 64;
    for (int it = MP * 160 + gid; it < MR * 20 * 8; it += NT) {
        const int i8 = it & 7, hh = (it >> 3) % 20, row = it / 160;
        const int col = hh < NH ? ZQ + hh * HD : ZK + (hh - NH) * HD, pi = row < MP ? (row & (SEQ - 1)) : SEQ;
        bf16* p1 = Z + (size_t)row * DIN + col + 8 * i8; const v4u a = *(const v4u*)p1, b = *(const v4u*)(p1 + 64);
        const f32x4 c0 = *(const f32x4*)(CS + pi * 64 + 8 * i8), c1 = *(const f32x4*)(CS + pi * 64 + 8 * i8 + 4), s0 = *(const f32x4*)(SN + pi * 64 + 8 * i8), s1 = *(const f32x4*)(SN + pi * 64 + 8 * i8 + 4);
        float x1[8], x2[8], o1[8], o2[8];
#pragma unroll
        for (int e = 0; e < 4; ++e) { x1[2 * e] = blo(a[e]); x1[2 * e + 1] = bhi(a[e]); x2[2 * e] = blo(b[e]); x2[2 * e + 1] = bhi(b[e]); }
#pragma unroll
        for (int e = 0; e < 8; ++e) { const float c = e < 4 ? c0[e & 3] : c1[e & 3], s = e < 4 ? s0[e & 3] : s1[e & 3]; o1[e] = x1[e] * c - x2[e] * s; o2[e] = x2[e] * c + x1[e] * s; }
        v4u w1, w2;
#pragma unroll
        for (int e = 0; e < 4; ++e) { w1[e] = pk2(o1[2 * e], o1[2 * e + 1]); w2[e] = pk2(o2[2 * e], o2[2 * e + 1]); }
        *(v4u*)p1 = w1; *(v4u*)(p1 + 64) = w2;
        if (hh >= NH) { const int kvh = hh - NH; float* dst = nullptr;
            if (row < MP) { const int t = row & (SEQ - 1), b_ = row / SEQ; if (t >= SEQ - WIN) dst = A->out + O_KP + ((((size_t)L * NBATCH + b_) * WIN + (t - (SEQ - WIN))) * NKV + kvh) * HD; }
            else dst = A->out + O_KS + ((((size_t)L * SBATCH + (row - MP)) * WIN + (WIN - 1)) * NKV + kvh) * HD;
            if (dst) { *(f32x4*)(dst + 8 * i8) = (f32x4){o1[0], o1[1], o1[2], o1[3]}; *(f32x4*)(dst + 8 * i8 + 4) = (f32x4){o1[4], o1[5], o1[6], o1[7]};
                       *(f32x4*)(dst + 64 + 8 * i8) = (f32x4){o2[0], o2[1], o2[2], o2[3]}; *(f32x4*)(dst + 64 + 8 * i8 + 4) = (f32x4){o2[4], o2[5], o2[6], o2[7]}; } }
    }
    for (int it = NBATCH * WIN * 64 + gid; it < (NBATCH * WIN + SBATCH) * 64; it += NT) { const int c8 = it & 63, rr = it >> 6; int row; float* dst;
        if (rr < NBATCH * WIN) { const int b_ = rr / WIN, j = rr % WIN; row = b_ * SEQ + (SEQ - WIN) + j; dst = A->out + O_VP + (((size_t)L * NBATCH + b_) * WIN + j) * (NKV * HD); }
        else { const int bs = rr - NBATCH * WIN; row = MP + bs; dst = A->out + O_VS + (((size_t)L * SBATCH + bs) * WIN + (WIN - 1)) * (NKV * HD); }
        const v4u a = *(const v4u*)(Z + (size_t)row * DIN + ZV + 8 * c8);
        *(f32x4*)(dst + 8 * c8) = (f32x4){blo(a.x), bhi(a.x), blo(a.y), bhi(a.y)}; *(f32x4*)(dst + 8 * c8 + 4) = (f32x4){blo(a.z), bhi(a.z), blo(a.w), bhi(a.w)}; }
    constexpr int ROW4 = NKV * HD / 4;
    constexpr int NSH = 2 * SBATCH * (WIN - 1) * ROW4;
    for (int it0 = gid; it0 < NSH; it0 += 8 * NT) { f32x4 v[8];
#pragma unroll
        for (int k = 0; k < 8; ++k) { const int it = it0 + k * NT; if (it < NSH) { const int kv = it / (SBATCH * (WIN - 1) * ROW4), r = it % (SBATCH * (WIN - 1) * ROW4), c4 = r % ROW4, j = (r / ROW4) % (WIN - 1), bs = r / (ROW4 * (WIN - 1));
            v[k] = ((const f32x4*)((kv ? A->in[5] : A->in[4]) + (((size_t)L * SBATCH + bs) * WIN + j + 1) * (NKV * HD)))[c4]; } }
        asm volatile("" ::: "memory"); __builtin_amdgcn_sched_barrier(0);
#pragma unroll
        for (int k = 0; k < 8; ++k) { const int it = it0 + k * NT; if (it < NSH) { const int kv = it / (SBATCH * (WIN - 1) * ROW4), r = it % (SBATCH * (WIN - 1) * ROW4), c4 = r % ROW4, j = (r / ROW4) % (WIN - 1), bs = r / (ROW4 * (WIN - 1));
            ((f32x4*)(A->out + (kv ? O_VS : O_KS) + (((size_t)L * SBATCH + bs) * WIN + j) * (NKV * HD)))[c4] = v[k]; } }
    }
}

__device__ __forceinline__ void ssm_prompt_unit(CArgs* A, int L, int unit, LAS unsigned char* wl, int lane) {
    const int b_ = unit / NG, g = unit % NG;
    LAS float* hre = (LAS float*)wl; LAS float* him = hre + 16 * 64; LAS float* ub = him + 16 * 64; LAS float* cre = ub + 256; LAS float* cim = cre + 16 * 64;
    const size_t gp = ((size_t)L * NG + g) * PS + lane;
    const float lr = ((const float*)(A->ws + WS_LAM))[2 * gp], li = ((const float*)(A->ws + WS_LAM))[2 * gp + 1];
    float Br[GC], Bi[GC];
#pragma unroll
    for (int c = 0; c < GC; c += 4) { const f32x4 r4 = *(const f32x4*)((const float*)(A->ws + WS_BBR) + gp * GC + c), i4 = *(const f32x4*)((const float*)(A->ws + WS_BBI) + gp * GC + c);
        Br[c] = r4.x; Br[c + 1] = r4.y; Br[c + 2] = r4.z; Br[c + 3] = r4.w; Bi[c] = i4.x; Bi[c + 1] = i4.y; Bi[c + 2] = i4.z; Bi[c + 3] = i4.w; }
#pragma unroll
    for (int c = 0; c < GC; ++c) { cre[c * 64 + lane] = A->in[17][(((size_t)L * NG + g) * GC + c) * PS + lane]; cim[c * 64 + lane] = A->in[18][(((size_t)L * NG + g) * GC + c) * PS + lane]; }
    const int t_ = lane >> 2, cq = lane & 3;
    float Dk[4];
#pragma unroll
    for (int i = 0; i < 4; ++i) Dk[i] = A->in[19][(size_t)L * DSSM + g * GC + 4 * cq + i];
    const bf16* Z = (const bf16*)(A->ws + WS_Z); bf16* Y = (bf16*)(A->ws + WS_YACT);
    float hr = 0.f, hi = 0.f;
    for (int blk = 0; blk < SEQ / 16; ++blk) {
        const int m0 = b_ * SEQ + blk * 16;
        { const v2u w = *(const v2u*)(Z + (size_t)(m0 + t_) * DIN + ZU + g * GC + 4 * cq); *(LAS f32x4*)(ub + t_ * 16 + 4 * cq) = (f32x4){blo(w.x), bhi(w.x), blo(w.y), bhi(w.y)}; }
        LDS_WAIT();
#pragma unroll 4
        for (int t = 0; t < 16; ++t) { float xr = 0.f, xi = 0.f;
#pragma unroll
            for (int c = 0; c < GC; c += 4) { const f32x4 u4 = *(const LAS f32x4*)(ub + t * 16 + c);
                xr += (Br[c] * u4.x + Br[c + 1] * u4.y) + (Br[c + 2] * u4.z + Br[c + 3] * u4.w); xi += (Bi[c] * u4.x + Bi[c + 1] * u4.y) + (Bi[c + 2] * u4.z + Bi[c + 3] * u4.w); }
            const float nr = lr * hr - li * hi + xr, ni = lr * hi + li * hr + xi; hr = nr; hi = ni; hre[t * 64 + lane] = hr; him[t * 64 + lane] = hi; }
        LDS_WAIT();
        float y[4] = {0.f, 0.f, 0.f, 0.f};
#pragma unroll 4
        for (int pq = 0; pq < 16; ++pq) { const f32x4 h4r = *(const LAS f32x4*)(hre + t_ * 64 + 4 * pq), h4i = *(const LAS f32x4*)(him + t_ * 64 + 4 * pq);
#pragma unroll
            for (int i = 0; i < 4; ++i) { const f32x4 cr = *(const LAS f32x4*)(cre + (4 * cq + i) * 64 + 4 * pq), ci = *(const LAS f32x4*)(cim + (4 * cq + i) * 64 + 4 * pq);
                y[i] += ((cr.x * h4r.x + cr.y * h4r.y) + (cr.z * h4r.z + cr.w * h4r.w)) - ((ci.x * h4i.x + ci.y * h4i.y) + (ci.z * h4i.z + ci.w * h4i.w)); } }
        { const f32x4 u4 = *(const LAS f32x4*)(ub + t_ * 16 + 4 * cq);
          const float o0 = gelu_tanh(y[0] + Dk[0] * u4.x), o1 = gelu_tanh(y[1] + Dk[1] * u4.y), o2 = gelu_tanh(y[2] + Dk[2] * u4.z), o3 = gelu_tanh(y[3] + Dk[3] * u4.w);
          v2u w; w.x = pk2(o0, o1); w.y = pk2(o2, o3); *(v2u*)(Y + (size_t)(m0 + t_) * DSSM + g * GC + 4 * cq) = w; }
        LDS_WAIT();
    }
    A->out[O_HRP + (((size_t)L * NBATCH + b_) * NG + g) * PS + lane] = hr; A->out[O_HIP + (((size_t)L * NBATCH + b_) * NG + g) * PS + lane] = hi;
}
__device__ __forceinline__ void ssm_sample_unit(CArgs* A, int L, int unit, int lane) {
    const int bs = unit / NG, g = unit % NG; const size_t gp = ((size_t)L * NG + g) * PS + lane;
    const float lr = ((const float*)(A->ws + WS_LAM))[2 * gp], li = ((const float*)(A->ws + WS_LAM))[2 * gp + 1];
    const bf16* zr = (const bf16*)(A->ws + WS_Z) + (size_t)(MP + bs) * DIN + ZU + g * GC; const v4u ua = *(const v4u*)zr, ub_ = *(const v4u*)(zr + 8);
    float u[GC];
#pragma unroll
    for (int e = 0; e < 4; ++e) { u[2 * e] = blo(ua[e]); u[2 * e + 1] = bhi(ua[e]); u[8 + 2 * e] = blo(ub_[e]); u[8 + 2 * e + 1] = bhi(ub_[e]); }
    float xr = 0.f, xi = 0.f;
#pragma unroll
    for (int c = 0; c < GC; ++c) { xr += ((const float*)(A->ws + WS_BBR))[gp * GC + c] * u[c]; xi += ((const float*)(A->ws + WS_BBI))[gp * GC + c] * u[c]; }
    const size_t si = (((size_t)L * SBATCH + bs) * NG + g) * PS + lane; const float h0r = A->in[6][si], h0i = A->in[7][si];
    const float hr = lr * h0r - li * h0i + xr, hi = lr * h0i + li * h0r + xi;
    A->out[O_HRS + si] = hr; A->out[O_HIS + si] = hi;
    float mine = 0.f;
#pragma unroll
    for (int c = 0; c < GC; ++c) { const size_t ci = (((size_t)L * NG + g) * GC + c) * PS + lane; const float yv = wave_sum(A->in[17][ci] * hr - A->in[18][ci] * hi); if (lane == c) mine = yv + A->in[19][(size_t)L * DSSM + g * GC + c] * u[c]; }
    if (lane < GC) ((bf16*)(A->ws + WS_YACT))[(size_t)(MP + bs) * DSSM + g * GC + lane] = (bf16)f2bf(gelu_tanh(mine));
}

__device__ __forceinline__ void load8(const bf16* p, float (&o)[8]) { const v4u a = *(const v4u*)p;
#pragma unroll
    for (int e = 0; e < 4; ++e) { o[2 * e] = blo(a[e]); o[2 * e + 1] = bhi(a[e]); } }
__device__ __forceinline__ void load8(const float* p, float (&o)[8]) { const f32x4 a = *(const f32x4*)p, b = *(const f32x4*)(p + 4); o[0] = a.x; o[1] = a.y; o[2] = a.z; o[3] = a.w; o[4] = b.x; o[5] = b.y; o[6] = b.z; o[7] = b.w; }
__device__ __forceinline__ void load2(const bf16* p, float& a, float& b) { const unsigned w = *(const unsigned*)p; a = blo(w); b = bhi(w); }
__device__ __forceinline__ void load2(const float* p, float& a, float& b) { const float2 w = *(const float2*)p; a = w.x; b = w.y; }
template <typename KT>
__device__ __forceinline__ void attn_task(const bf16* qrow, const KT* Kself, const KT* Vself, size_t kstride, int nkeys, float sink, const bf16* gate, bf16* orow, int lane) {
    const bool v0 = lane < nkeys, v1 = lane + 64 < nkeys;
    const KT* k0 = Kself - (size_t)(v0 ? lane : 0) * kstride; const KT* k1 = Kself - (size_t)(v1 ? lane + 64 : 0) * kstride;
    float s0 = 0.f, s1 = 0.f;
#pragma unroll 4
    for (int c = 0; c < 16; ++c) { float q8[8], a8[8], b8[8]; load8(qrow + 8 * c, q8); load8(k0 + 8 * c, a8); load8(k1 + 8 * c, b8);
#pragma unroll
        for (int e = 0; e < 8; ++e) { s0 += q8[e] * a8[e]; s1 += q8[e] * b8[e]; } }
    s0 = v0 ? s0 * ATT_SCALE : -INFINITY; s1 = v1 ? s1 * ATT_SCALE : -INFINITY;
    const float m = fmaxf(wave_max(fmaxf(s0, s1)), sink);
    const float p0 = v0 ? __expf(s0 - m) : 0.f, p1 = v1 ? __expf(s1 - m) : 0.f;
    const float den = wave_sum(p0 + p1) + __expf(sink - m);
    float o0 = 0.f, o1 = 0.f;
    const KT* vp = Vself + 2 * lane;
#pragma unroll 1
    for (int i0 = 0; i0 < 128; i0 += 16) { if (i0 >= nkeys) break; float va[16], vb_[16];
#pragma unroll
        for (int j = 0; j < 16; ++j) { const int i = i0 + j; load2(vp - (size_t)(i < nkeys ? i : 0) * kstride, va[j], vb_[j]); }
#pragma unroll
        for (int j = 0; j < 16; ++j) { const int i = i0 + j; const float pi = __builtin_bit_cast(float, __builtin_amdgcn_readlane(__builtin_bit_cast(int, i0 < 64 ? p0 : p1), i & 63)); o0 += pi * va[j]; o1 += pi * vb_[j]; } }
    float ga, gb; load2(gate + 2 * lane, ga, gb);
    const float inv = 1.0f / den;
    *(unsigned*)(orow + 2 * lane) = pk2(o0 * inv * ga * sigm(ga), o1 * inv * gb * sigm(gb));
}
__device__ __forceinline__ void attn_phase(CArgs* A, int L, int gw, int NGW, int lane) {
    const bf16* Z = (const bf16*)(A->ws + WS_Z); bf16* CAT = (bf16*)(A->ws + WS_CAT);
    for (int task = gw; task < MR * NH; task += NGW) {
        const int row = task / NH, h = task % NH, kvh = h / (NH / NKV);
        const float sink = A->in[22][L * NH + h];
        const bf16* zr = Z + (size_t)row * DIN; bf16* orow = CAT + (size_t)row * DM + DSSM + h * HD;
        if (row < MP) { const int t = row & (SEQ - 1); attn_task<bf16>(zr + ZQ + h * HD, zr + ZK + kvh * HD, zr + ZV + kvh * HD, (size_t)DIN, t + 1 < WIN ? t + 1 : WIN, sink, zr + ZGA + h * HD, orow, lane); }
        else { const int bs = row - MP; const size_t wo = ((((size_t)L * SBATCH + bs) * WIN + (WIN - 1)) * NKV + kvh) * HD;
            attn_task<float>(zr + ZQ + h * HD, A->out + O_KS + wo, A->out + O_VS + wo, (size_t)(NKV * HD), WIN, sink, zr + ZGA + h * HD, orow, lane); }
    }
}
typedef float f32x16 __attribute__((ext_vector_type(16)));
typedef short s16x4 __attribute__((ext_vector_type(4)));
#define KSWZ(row, colB) ((row) * 256 + ((colB) ^ (((row) & 7) << 4)))
#define SBAR() __builtin_amdgcn_sched_barrier(0)
constexpr float ATT_THR = 4.f;
__device__ __forceinline__ int crow(int r, int hi) { return (r & 3) + 8 * (r >> 2) + 4 * hi; }
__device__ __forceinline__ unsigned cvtpk(float lo, float hi) { unsigned r; asm volatile("v_cvt_pk_bf16_f32 %0, %1, %2" : "=v"(r) : "v"(lo), "v"(hi)); return r; }
__device__ __forceinline__ void partialSM(f32x16& p0, f32x16& p1, float& m_reg, float& alpha) {
    constexpr float C = ATT_SCALE * 1.4426950408889634f;
    float pmax = p0[0];
#pragma unroll
    for (int r = 1; r < 16; ++r) pmax = fmaxf(pmax, p0[r]);
#pragma unroll
    for (int r = 0; r < 16; ++r) pmax = fmaxf(pmax, p1[r]);
    { auto rr = __builtin_amdgcn_permlane32_swap(__float_as_uint(pmax), __float_as_uint(pmax), false, false); pmax = fmaxf(__uint_as_float(rr[0]), __uint_as_float(rr[1])); }
    float mn;
    if (__builtin_expect(__all(pmax - m_reg <= ATT_THR / ATT_SCALE), 1)) { mn = m_reg; alpha = 1.f; }
    else { mn = fmaxf(m_reg, pmax); alpha = __builtin_amdgcn_exp2f((m_reg - mn) * C); m_reg = mn; }
    const float mnC = -mn * C;
#pragma unroll
    for (int r = 0; r < 16; ++r) { p0[r] = __builtin_amdgcn_exp2f(fmaf(p0[r], C, mnC)); p1[r] = __builtin_amdgcn_exp2f(fmaf(p1[r], C, mnC)); }
}
__device__ __forceinline__ void finishSM(const f32x16& p0, const f32x16& p1, float alpha, float& l_reg, bf16x8& pa0, bf16x8& pa1, bf16x8& pa2, bf16x8& pa3) {
    float ps = 0.f;
#pragma unroll
    for (int r = 0; r < 16; ++r) ps += p0[r] + p1[r];
    { auto rr = __builtin_amdgcn_permlane32_swap(__float_as_uint(ps), __float_as_uint(ps), false, false); ps = __uint_as_float(rr[0]) + __uint_as_float(rr[1]); }
    l_reg = l_reg * alpha + ps;
#define PK4(P, BASE, OUT) do { unsigned a0 = cvtpk(P[BASE + 0], P[BASE + 1]), a1 = cvtpk(P[BASE + 2], P[BASE + 3]); unsigned b0 = cvtpk(P[BASE + 4], P[BASE + 5]), b1 = cvtpk(P[BASE + 6], P[BASE + 7]); \
    auto r0 = __builtin_amdgcn_permlane32_swap(a0, b0, false, false); auto r1 = __builtin_amdgcn_permlane32_swap(a1, b1, false, false); v4u w = {r0[0], r1[0], r0[1], r1[1]}; OUT = __builtin_bit_cast(bf16x8, w); } while (0)
    PK4(p0, 0, pa0); PK4(p0, 8, pa1); PK4(p1, 0, pa2); PK4(p1, 8, pa3);
#undef PK4
}
__device__ __forceinline__ void qkt(f32x16& p0, f32x16& p1, const LAS unsigned char* Ks, const bf16x8 (&qr)[8], int r32, int hi) {
#pragma unroll
    for (int r = 0; r < 16; ++r) { p0[r] = 0.f; p1[r] = 0.f; }
#pragma unroll
    for (int d0 = 0; d0 < 8; ++d0) { const int cb = (d0 * 16 + hi * 8) * 2;
        const bf16x8 b0 = *(const LAS bf16x8*)(Ks + KSWZ(r32, cb)), b1 = *(const LAS bf16x8*)(Ks + KSWZ(32 + r32, cb));
        p0 = __builtin_amdgcn_mfma_f32_32x32x16_bf16(b0, qr[d0], p0, 0, 0, 0); p1 = __builtin_amdgcn_mfma_f32_32x32x16_bf16(b1, qr[d0], p1, 0, 0, 0); }
}
__device__ __forceinline__ int v_st(int k, int c) { const int kk = (k & ~0xC) | ((k & 4) << 1) | ((k & 8) >> 1); return ((kk >> 3) * 4 + (c >> 5)) * 512 + ((kk & 7) * 32 + (c & 31)) * 2; }
__device__ __forceinline__ int v_rd_base(int lane) { return ((lane & 3) << 3) | (((lane >> 2) & 3) << 6) | (((lane >> 4) & 1) << 5) | (((lane >> 5) & 1) << 8); }
constexpr int v_rd_off(int d0, int ks, int half) { return d0 * 512 + ks * 4096 + half * 2048; }
template <int OFF> __device__ __forceinline__ s16x4 tr_read(int vb) { s16x4 r; asm volatile("ds_read_b64_tr_b16 %0, %1 offset:%2" : "=&v"(r) : "v"(vb), "i"(OFF) : "memory"); return r; }
template <int D0> __device__ __forceinline__ void pv_one(f32x16& od, int vb, bf16x8 pa0, bf16x8 pa1, bf16x8 pa2, bf16x8 pa3) {
    const s16x4 l0 = tr_read<v_rd_off(D0, 0, 0)>(vb), h0 = tr_read<v_rd_off(D0, 0, 1)>(vb), l1 = tr_read<v_rd_off(D0, 1, 0)>(vb), h1 = tr_read<v_rd_off(D0, 1, 1)>(vb);
    const s16x4 l2 = tr_read<v_rd_off(D0, 2, 0)>(vb), h2 = tr_read<v_rd_off(D0, 2, 1)>(vb), l3 = tr_read<v_rd_off(D0, 3, 0)>(vb), h3 = tr_read<v_rd_off(D0, 3, 1)>(vb);
    asm volatile("s_waitcnt lgkmcnt(0)" ::: "memory"); SBAR();
#define PKV(L, H) (bf16x8){L[0], L[1], L[2], L[3], H[0], H[1], H[2], H[3]}
    od = __builtin_amdgcn_mfma_f32_32x32x16_bf16(PKV(l0, h0), pa0, od, 0, 0, 0); od = __builtin_amdgcn_mfma_f32_32x32x16_bf16(PKV(l1, h1), pa1, od, 0, 0, 0);
    od = __builtin_amdgcn_mfma_f32_32x32x16_bf16(PKV(l2, h2), pa2, od, 0, 0, 0); od = __builtin_amdgcn_mfma_f32_32x32x16_bf16(PKV(l3, h3), pa3, od, 0, 0, 0);
#undef PKV
}
constexpr int AL_K = 0, AL_V = 65536, AL_WS = 131072;
__device__ __forceinline__ void attn_stage(CArgs* A, int u, LAS unsigned char* lds, int tid) {
    const int kvh = u & 3, qblk = (u >> 2) & 15, b_ = u >> 6; const bf16* Z = (const bf16*)(A->ws + WS_Z);
    const int m0 = b_ * SEQ + qblk * 128, tmin = qblk == 0 ? 2 : 0;
    const int sr = tid >> 4, sc = (tid & 15) * 8, vst0 = v_st(sr, sc), vst1 = v_st(32 + sr, sc);
    v4u kreg[4][2], vreg[4][2];
#pragma unroll
    for (int kt = 0; kt < 4; ++kt) if (kt >= tmin) {
#pragma unroll
        for (int h2 = 0; h2 < 2; ++h2) { const bf16* rowp = Z + (size_t)(m0 - 128 + 64 * kt + 32 * h2 + sr) * DIN + kvh * HD + sc; kreg[kt][h2] = *(const v4u*)(rowp + ZK); vreg[kt][h2] = *(const v4u*)(rowp + ZV); } }
#pragma unroll
    for (int kt = 0; kt < 4; ++kt) if (kt >= tmin) {
        *(LAS v4u*)(lds + AL_K + kt * 16384 + KSWZ(sr, sc * 2)) = kreg[kt][0]; *(LAS v4u*)(lds + AL_K + kt * 16384 + KSWZ(32 + sr, sc * 2)) = kreg[kt][1];
        *(LAS v4u*)(lds + AL_V + kt * 16384 + vst0) = vreg[kt][0]; *(LAS v4u*)(lds + AL_V + kt * 16384 + vst1) = vreg[kt][1]; }
    LDS_WAIT();
}
__device__ __forceinline__ void attn_mfma_unit(CArgs* A, int L, int u, LAS unsigned char* lds, int tid, int lane, int wave, bool staged) {
    const int kvh = u & 3, qblk = (u >> 2) & 15, b_ = u >> 6, r32 = lane & 31, hi = lane >> 5;
    const bf16* Z = (const bf16*)(A->ws + WS_Z);
    const int m0 = b_ * SEQ + qblk * 128;
    const int tmin = qblk == 0 ? 2 : 0;
    if (!staged) { __syncthreads();
        attn_stage(A, u, lds, tid); }
    __syncthreads();
    const int hq = kvh * (NH / NKV) + (wave >> 1), td = 2 + (wave & 1);
    const float sinkC = A->in[22][L * NH + hq] * 1.4426950408889634f;
    constexpr float C = ATT_SCALE * 1.4426950408889634f;
    const int vbase = (int)(uintptr_t)(lds + AL_V) + v_rd_base(lane);
#pragma unroll 1
    for (int sbr = 0; sbr < 2 * REP_ASB; ++sbr) { const int sb = sbr & 1;
        const int i = 2 * (wave & 1) + sb, rloc = 32 * i + r32;
        bf16x8 qr[8];
        { const bf16* qp = Z + (size_t)(m0 + rloc) * DIN + ZQ + hq * HD + hi * 8;
#pragma unroll
          for (int d0 = 0; d0 < 8; ++d0) qr[d0] = *(const bf16x8*)(qp + d0 * 16); }
        v2u gv[4][4];
        { const bf16* gp = Z + (size_t)(m0 + rloc) * DIN + ZGA + hq * HD + 4 * hi;
#pragma unroll
          for (int d = 0; d < 4; ++d)
#pragma unroll
            for (int g4 = 0; g4 < 4; ++g4) gv[d][g4] = *(const v2u*)(gp + 32 * d + 8 * g4); }
        float m_reg = -1e30f, l_reg = 0.f; f32x16 o[4];
#pragma unroll
        for (int d = 0; d < 4; ++d)
#pragma unroll
            for (int r = 0; r < 16; ++r) o[d][r] = 0.f;
#pragma unroll
        for (int kk = 0; kk < 3; ++kk) { const int kt = td - kk; if (kt < tmin) break;
            f32x16 p0, p1; float alpha; bf16x8 pa0, pa1, pa2, pa3;
            qkt(p0, p1, lds + AL_K + kt * 16384, qr, r32, hi);
            if (kt != td - 1) {
                const int base = 64 * kt + 4 * hi - rloc - 1;
#pragma unroll
                for (int r = 0; r < 16; ++r) { const int kr = (r & 3) + 8 * (r >> 2);
                    p0[r] = (unsigned)(base + kr) < 128u ? p0[r] : -INFINITY; p1[r] = (unsigned)(base + kr + 32) < 128u ? p1[r] : -INFINITY; } }
            partialSM(p0, p1, m_reg, alpha);
            finishSM(p0, p1, alpha, l_reg, pa0, pa1, pa2, pa3);
            if (__any(alpha < 1.f)) {
#pragma unroll
                for (int r = 0; r < 16; ++r)
#pragma unroll
                    for (int d = 0; d < 4; ++d) o[d][r] *= alpha; }
            SBAR();
            const int vb = vbase + kt * 16384;
            pv_one<0>(o[0], vb, pa0, pa1, pa2, pa3); pv_one<1>(o[1], vb, pa0, pa1, pa2, pa3); pv_one<2>(o[2], vb, pa0, pa1, pa2, pa3); pv_one<3>(o[3], vb, pa0, pa1, pa2, pa3);
        }
        l_reg += __builtin_amdgcn_exp2f(sinkC - m_reg * C);
        const float rl = __builtin_amdgcn_rcpf(l_reg);
        bf16* op = (bf16*)(A->ws + WS_CAT) + (size_t)(m0 + rloc) * DM + DSSM + hq * HD + 8 * hi;
#pragma unroll
        for (int d = 0; d < 4; ++d)
#pragma unroll
            for (int gp2 = 0; gp2 < 4; gp2 += 2) { unsigned w[2][2];
#pragma unroll
                for (int k = 0; k < 2; ++k) { const int g4 = gp2 + k; const v2u g2 = gv[d][g4]; const float g0 = blo(g2.x), g1 = bhi(g2.x), g2_ = blo(g2.y), g3 = bhi(g2.y);
                    w[k][0] = cvtpk(o[d][4 * g4 + 0] * rl * g0 * sigm(g0), o[d][4 * g4 + 1] * rl * g1 * sigm(g1)); w[k][1] = cvtpk(o[d][4 * g4 + 2] * rl * g2_ * sigm(g2_), o[d][4 * g4 + 3] * rl * g3 * sigm(g3)); }
                auto r0 = __builtin_amdgcn_permlane32_swap(w[0][0], w[1][0], false, false); auto r1 = __builtin_amdgcn_permlane32_swap(w[0][1], w[1][1], false, false);
                v4u wv = {r0[0], r1[0], r0[1], r1[1]}; *(v4u*)(op + 32 * d + 8 * gp2) = wv; }
    }
}
__device__ __forceinline__ void attn_sample(CArgs* A, int L, int st0, int nst, int lane) {
#pragma unroll 1
    for (int rep = 0; rep < REP_ATS; ++rep)
#pragma unroll 1
    for (int st = st0; st < SBATCH * NH; st += nst) { const int bs = st / NH, h = st % NH, kvh = h / (NH / NKV), row = MP + bs; const bf16* zr = (const bf16*)(A->ws + WS_Z) + (size_t)row * DIN;
        const size_t wo = ((((size_t)L * SBATCH + bs) * WIN + (WIN - 1)) * NKV + kvh) * HD;
        attn_task<float>(zr + ZQ + h * HD, A->out + O_KS + wo, A->out + O_VS + wo, (size_t)(NKV * HD), WIN, A->in[22][L * NH + h], zr + ZGA + h * HD, (bf16*)(A->ws + WS_CAT) + (size_t)row * DM + DSSM + h * HD, lane); }
}
__device__ __forceinline__ void attn_phase2(CArgs* A, int L, LAS unsigned char* lds, int tid, int lane, int wave, bool prestaged) {
#pragma unroll 1
    for (int rep = 0; rep < REP_ATU; ++rep)
    { const int Gq = (int)gridDim.x, vcu = (Gq % 8 == 0) ? ((int)blockIdx.x % 8) * (Gq / 8) + (int)blockIdx.x / 8 : (int)blockIdx.x;
      for (int u = vcu; u < NBATCH * (SEQ / 128) * NKV; u += gridDim.x) attn_mfma_unit(A, L, u, lds, tid, lane, wave, prestaged && u == vcu); }
    __syncthreads();
}
template <int NT, class Epi>
__device__ __forceinline__ void skinny_gemm(const bf16* act, int lda, const bf16* Wt, int K, int n0, LAS unsigned char* lds, int tid, int lane, int wave, const Epi& E) {
    const int r = lane & 15, q = lane >> 4, kw = K / NWAVES, kbeg = wave * kw;
    f32x4 acc[NT][2];
#pragma unroll
    for (int t = 0; t < NT; ++t) { acc[t][0] = (f32x4){0.f, 0.f, 0.f, 0.f}; acc[t][1] = (f32x4){0.f, 0.f, 0.f, 0.f}; }
    const bf16* ap = act + (size_t)r * lda + kbeg + 32 * q; const bf16* wp = Wt + (size_t)(n0 + r) * K + kbeg + 32 * q;
    bf16x8 bfA[2][4], afA[NT][4], bfB[2][4], afB[NT][4];
#define SK_LOAD(BF, AF, K0) do { _Pragma("unroll") for (int mt = 0; mt < 2; ++mt) _Pragma("unroll") for (int i = 0; i < 4; ++i) BF[mt][i] = *(const bf16x8*)(ap + (size_t)(16 * mt) * lda + (K0) + 8 * i); \
        _Pragma("unroll") for (int t = 0; t < NT; ++t) _Pragma("unroll") for (int i = 0; i < 4; ++i) AF[t][i] = *(const bf16x8*)(wp + (size_t)(16 * t) * K + (K0) + 8 * i); } while (0)
#define SK_COMP(BF, AF) do { _Pragma("unroll") for (int t = 0; t < NT; ++t) _Pragma("unroll") for (int i = 0; i < 4; ++i) { acc[t][0] = MFMA16(AF[t][i], BF[0][i], acc[t][0]); acc[t][1] = MFMA16(AF[t][i], BF[1][i], acc[t][1]); } } while (0)
    SK_LOAD(bfA, afA, 0); if (kw > 128) SK_LOAD(bfB, afB, 128);
    for (int k0 = 0; k0 < kw; k0 += 256) {
        SK_COMP(bfA, afA); if (k0 + 256 < kw) SK_LOAD(bfA, afA, k0 + 256);
        if (k0 + 128 < kw) { SK_COMP(bfB, afB); if (k0 + 384 < kw) SK_LOAD(bfB, afB, k0 + 384); }
    }
#undef SK_LOAD
#undef SK_COMP
    __syncthreads();
    LAS f32x4* Pp = (LAS f32x4*)lds;
#pragma unroll
    for (int t = 0; t < NT; ++t) { Pp[((wave * NT + t) * 2 + 0) * 64 + lane] = acc[t][0]; Pp[((wave * NT + t) * 2 + 1) * 64 + lane] = acc[t][1]; }
    __syncthreads();
    for (int e = tid; e < NT * 128; e += NTHR) { const int t = e >> 7, mt = (e >> 6) & 1, l = e & 63; f32x4 s = Pp[((0 * NT + t) * 2 + mt) * 64 + l];
#pragma unroll
        for (int w = 1; w < NWAVES; ++w) s += Pp[((w * NT + t) * 2 + mt) * 64 + l];
        E(16 * mt + (l & 15), n0 + 16 * t + 4 * (l >> 4), s); }
}
template <class Epi>
__device__ __forceinline__ void skinny_gemm1_flat(const bf16* act, int lda, const bf16* Wt, int K, int n0, LAS unsigned char* lds, int tid, int lane, int wave, const Epi& E) {
    if (K / NWAVES != 512) { skinny_gemm<1>(act, lda, Wt, K, n0, lds, tid, lane, wave, E); return; }
    const int r = lane & 15, q = lane >> 4, kbeg = wave * 512;
    const bf16* ap = act + (size_t)r * lda + kbeg + 32 * q; const bf16* wp = Wt + (size_t)(n0 + r) * K + kbeg + 32 * q;
    bf16x8 bfr[4][2][4], afr[4][4];
#pragma unroll
    for (int st = 0; st < 4; ++st) {
#pragma unroll
        for (int i = 0; i < 4; ++i) { afr[st][i] = *(const bf16x8*)(wp + 128 * st + 8 * i); bfr[st][0][i] = *(const bf16x8*)(ap + 128 * st + 8 * i); bfr[st][1][i] = *(const bf16x8*)(ap + (size_t)16 * lda + 128 * st + 8 * i); } }
    f32x4 a0 = (f32x4){0.f, 0.f, 0.f, 0.f}, a1 = a0;
#pragma unroll
    for (int st = 0; st < 4; ++st)
#pragma unroll
        for (int i = 0; i < 4; ++i) { a0 = MFMA16(afr[st][i], bfr[st][0][i], a0); a1 = MFMA16(afr[st][i], bfr[st][1][i], a1); }
    __syncthreads();
    LAS f32x4* Pp = (LAS f32x4*)lds;
    Pp[(wave * 2 + 0) * 64 + lane] = a0; Pp[(wave * 2 + 1) * 64 + lane] = a1;
    __syncthreads();
    for (int e = tid; e < 128; e += NTHR) { const int mt = (e >> 6) & 1, l = e & 63; f32x4 sm = Pp[(0 * 2 + mt) * 64 + l];
#pragma unroll
        for (int w = 1; w < NWAVES; ++w) sm += Pp[(w * 2 + mt) * 64 + l];
        E(16 * mt + (l & 15), n0 + 4 * (l >> 4), sm); }
}
struct SkEpiZ { bf16* Zs;
    __device__ __forceinline__ void operator()(int m, int n, f32x4 a) const { v2u w; w.x = pk2(a.x, a.y); w.y = pk2(a.z, a.w); *(v2u*)(Zs + (size_t)m * DIN + rot_true(n)) = w; } };
struct SkEpiGlu { const bf16* Ys; const bf16* Gs; const float* bias; bf16* Cs;
    __device__ __forceinline__ void operator()(int m, int n, f32x4 a) const { const v2u y = *(const v2u*)(Ys + (size_t)m * DSSM + n), g = *(const v2u*)(Gs + (size_t)m * DIN + n); const f32x4 b = *(const f32x4*)(bias + n);
        const float y0 = blo(y.x), y1 = bhi(y.x), y2 = blo(y.y), y3 = bhi(y.y), g0 = blo(g.x), g1 = bhi(g.x), g2 = blo(g.y), g3 = bhi(g.y);
        v2u w; w.x = pk2(y0 * sigm(a.x + b.x) * g0 * sigm(g0), y1 * sigm(a.y + b.y) * g1 * sigm(g1)); w.y = pk2(y2 * sigm(a.z + b.z) * g2 * sigm(g2), y3 * sigm(a.w + b.w) * g3 * sigm(g3));
        *(v2u*)(Cs + (size_t)m * DM + n) = w; } };
struct SkEpiOut { const float* Xin; float* Xs; const float* gate;
    __device__ __forceinline__ void operator()(int m, int n, f32x4 a) const { const f32x4 x = *(const f32x4*)(Xin + (size_t)m * DM + n), gt = *(const f32x4*)(gate + (size_t)m * 3 * DM + n); *(f32x4*)(Xs + (size_t)m * DM + n) = x + gt * a; } };
#define REP_PRO 1
#define REP_NORM 1
#define REP_GIN 1
#define REP_SSM 1
#define REP_ATT 1
#define REP_GLU 1
#define REP_OUT 1
#ifndef MK_ONE_LAUNCH
#define MK_ONE_LAUNCH 1
#endif
__global__ void __launch_bounds__(NTHR, 2) fwd(Args args) {
    extern __shared__ __attribute__((aligned(16))) unsigned char lds_raw[];
    LAS unsigned char* lds = (LAS unsigned char*)lds_raw;
    const int tid0 = threadIdx.x; const int wave_s = __builtin_amdgcn_readfirstlane(tid0 >> 6);
    const int G = gridDim.x, NGW = G * NWAVES, NT = G * NTHR;
#define FRESH() int tid = wave_s * 64 + lane_id_fresh(); asm volatile("" : "+v"(tid));     const int lane = tid & 63, wave = __builtin_amdgcn_readfirstlane(tid >> 6), gw = blockIdx.x * NWAVES + wave, gid = blockIdx.x * NTHR + tid; (void)lane; (void)wave; (void)gw; (void)gid
    volatile LAS unsigned* MISC = (volatile LAS unsigned*)(lds + MISC_OFF);
    for (int u = tid0; u < (LDS_BYTES - LDSCTL_OFF) / 4; u += NTHR) ((LAS unsigned*)(lds + LDSCTL_OFF))[u] = 0u;
    __syncthreads();
    const int lo = args.ph_lo, hi = args.ph_hi;
    XcdBarrier bar; bar.bar = (unsigned*)(args.ws + WS_CTL) + CW_BAR; bar.x = 0; bar.st = nullptr;
    if (hi - lo > 1) bar = xcd_barrier_post((unsigned*)(args.ws + WS_CTL) + CW_BAR, MISC + 8);
    if (pg8::SplitOrder::short_share(G, (int)blockIdx.x) && tid0 == 0) (void)xb_add((unsigned*)(args.ws + WS_CTL) + CW_BAR2 + XB_XCNT(xb_xcc_id()), 1u);
#define IN(k) (lo <= (k) && (k) < hi)
#define SEAM(k) do { if (hi > (k) + 1) xcd_barrier(bar); } while (0)

    if (IN(0)) { FRESH(); pre_phase(kargs(), gid, NT); SEAM(0); }
    if (IN(1)) { FRESH();
#pragma unroll 1
        for (int rep = 0; rep < REP_PRO; ++rep) pro_phase(kargs(), lds, tid, lane, wave);
        SEAM(1); }
    for (int L = 0; L < DEPTH; ++L) {
        const int base = 2 + 5 * L;
        if (IN(base)) { FRESH();
#pragma unroll 1
            for (int rep = 0; rep < REP_NORM; ++rep) norm_phase(kargs(), L, 0, MR, gw, NGW, lane);
            SEAM(base); }
        if (IN(base + 1)) {
            {
                FRESH(); CArgs* B_ = kargs(); const int bx_ = (int)blockIdx.x, nsk = (G == 256) ? 128 : G, c_ = (G == 256) ? (bx_ % 8 - 4) * 32 + bx_ / 8 : bx_;
                if (pg8::SplitOrder::short_share(G, bx_)) {
                    XcdBarrier sb; sb.bar = (unsigned*)(B_->ws + WS_CTL) + CW_BAR2; sb.x = xb_xcc_id(); sb.st = MISC + 10;
                    { SkEpiZ SE{(bf16*)(B_->ws + WS_Z) + (size_t)MP * DIN};
                      if (G == 256) {
                        const int p9 = 9 * (c_ >> 1);
                        if (c_ & 1) skinny_gemm<4>((const bf16*)(B_->ws + WS_H) + (size_t)MP * DM, DM, (const bf16*)(B_->ws + WS_WIN) + (size_t)L * DIN * DM, DM, 16 * (p9 + 5), lds, tid, lane, wave, SE);
                        else        skinny_gemm<5>((const bf16*)(B_->ws + WS_H) + (size_t)MP * DM, DM, (const bf16*)(B_->ws + WS_WIN) + (size_t)L * DIN * DM, DM, 16 * p9, lds, tid, lane, wave, SE);
                      } else for (int grp = c_; grp < DIN / 48; grp += nsk)
                        skinny_gemm<3>((const bf16*)(B_->ws + WS_H) + (size_t)MP * DM, DM, (const bf16*)(B_->ws + WS_WIN) + (size_t)L * DIN * DM, DM, 48 * grp, lds, tid, lane, wave, SE); }
                    for (int t = c_; t < NG; t += nsk) ssm_prep_task(B_, L, t, lds, tid);
                    xcd_barrier_n(sb, (unsigned)nsk);
                    rope_phase(kargs(), L, c_ * NTHR + tid, nsk * NTHR);
                    for (int u = c_ * NWAVES + wave; u < SBATCH * NG; u += nsk * NWAVES) ssm_sample_unit(kargs(), L, u, lane);
                    xcd_barrier_n(sb, (unsigned)nsk);
                    { CArgs* C_ = kargs(); const int hh = nsk / 2 > 0 ? nsk / 2 : 1;
                      if (c_ < hh) attn_sample(C_, L, c_ * NWAVES + wave, hh * NWAVES, lane);
                      else { SkEpiGlu SE{(const bf16*)(C_->ws + WS_YACT) + (size_t)MP * DSSM, (const bf16*)(C_->ws + WS_Z) + (size_t)MP * DIN + ZG, C_->in[21] + (size_t)L * DSSM, (bf16*)(C_->ws + WS_CAT) + (size_t)MP * DM};
                        for (int g2 = c_ - hh; g2 < DSSM / 32; g2 += nsk - hh)
                            skinny_gemm<2>((const bf16*)(C_->ws + WS_YACT) + (size_t)MP * DSSM, DSSM, (const bf16*)(C_->ws + WS_WGLU) + (size_t)L * DSSM * DSSM, DSSM, 32 * g2, lds, tid, lane, wave, SE); } }
                    __syncthreads();
                }
            }
            { CArgs* A = kargs();
            pg8::Gemm g{(const pg8::bf16_t*)(A->ws + WS_H), (const pg8::bf16_t*)(A->ws + WS_WIN) + (size_t)L * DIN * DM, MP, DIN, DM}; pg8::SplitOrder S; S.init(MP, DIN, G, (int)blockIdx.x);
            pg8::EpiIn E{(pg8::bf16_t*)(A->ws + WS_Z), DIN, (const float*)(A->ws + WS_ROPE), (const float*)(A->ws + WS_ROPE) + (SEQ + 1) * 64, A->out + O_KP + (size_t)L * NBATCH * WIN * NKV * HD, A->out + O_VP + (size_t)L * NBATCH * WIN * NKV * HD, (pg8::bf16_t*)(A->ws + WS_U), MP};
#pragma unroll 1
            for (int rep = 0; rep < REP_GIN; ++rep) pg8::gemm_phase<pg8::EpiIn, pg8::SplitOrder, true, true>(lds, g, S, E, wave_s * 64 + lane_id_fresh());
            }
            SEAM(base + 1);
        }
        if (IN(base + 2)) { FRESH();
#pragma unroll 1
            for (int rep = 0; rep < REP_SSM; ++rep) ssm_mfma_phase(kargs(), L, lds, tid, lane, wave);
            if (IN(base + 3)) {
                const int vcu = (G % 8 == 0) ? ((int)blockIdx.x % 8) * (G / 8) + (int)blockIdx.x / 8 : (int)blockIdx.x;
                if (vcu < NBATCH * (SEQ / 128) * NKV) attn_stage(kargs(), vcu, lds, wave_s * 64 + lane_id_fresh()); }
            SEAM(base + 2);
        }
        if (IN(base + 3)) {
            { FRESH();
#pragma unroll 1
              for (int rep = 0; rep < REP_ATT; ++rep) attn_phase2(kargs(), L, lds, tid, lane, wave, IN(base + 2)); }
            { CArgs* A = kargs();
              pg8::Gemm g{(const pg8::bf16_t*)(A->ws + WS_YACT), (const pg8::bf16_t*)(A->ws + WS_WGLU) + (size_t)L * DSSM * DSSM, MP, DSSM, DSSM}; pg8::StaticOrder S; S.init(MP, DSSM, G, (int)blockIdx.x);
              pg8::EpiGlu E{(const pg8::bf16_t*)(A->ws + WS_YACT), DSSM, (const pg8::bf16_t*)(A->ws + WS_Z) + ZG, DIN, A->in[21] + (size_t)L * DSSM, (pg8::bf16_t*)(A->ws + WS_CAT), DM};
#pragma unroll 1
              for (int rep = 0; rep < REP_GLU; ++rep) pg8::gemm_phase<pg8::EpiGlu, pg8::StaticOrder, true, true>(lds, g, S, E, wave_s * 64 + lane_id_fresh()); }
            SEAM(base + 3);
        }
        if (IN(base + 4)) {
#define OUT_SAMPLE() do { FRESH(); CArgs* B_ = kargs(); SkEpiOut SE{L == 0 ? B_->in[1] : (const float*)(B_->out + (size_t)MP * DM), B_->out + (size_t)MP * DM, (const float*)(B_->ws + WS_MOD) + ((size_t)L * NB36 + NBATCH) * 3 * DM + 2 * DM}; \
                for (int grp = (int)blockIdx.x; grp < DM / 16; grp += G) \
                    skinny_gemm1_flat((const bf16*)(B_->ws + WS_CAT) + (size_t)MP * DM, DM, (const bf16*)(B_->ws + WS_WOUT) + (size_t)L * DM * DM, DM, 16 * grp, lds, tid, lane, wave, SE); \
                __syncthreads(); } while (0)
            if ((int)blockIdx.x & 1) OUT_SAMPLE();
            { CArgs* A = kargs();
              pg8::Gemm g{(const pg8::bf16_t*)(A->ws + WS_CAT), (const pg8::bf16_t*)(A->ws + WS_WOUT) + (size_t)L * DM * DM, MP, DM, DM}; pg8::StaticOrder S; S.init(MP, DM, G, (int)blockIdx.x);
              pg8::EpiOutB E{L == 0 ? A->in[0] : nullptr, (const pg8::bf16_t*)(A->ws + WS_XB), (pg8::bf16_t*)(A->ws + WS_XB), DM, (const float*)(A->ws + WS_MOD) + (size_t)L * NB36 * 3 * DM + 2 * DM, 3 * DM, 11};
              pg8::gemm_phase<pg8::EpiOutB, pg8::StaticOrder, true, true>(lds, g, S, E, wave_s * 64 + lane_id_fresh()); }
            if (!((int)blockIdx.x & 1)) OUT_SAMPLE();
#undef OUT_SAMPLE
            SEAM(base + 4);
        }
    }
    if (IN(NPHASE - 1)) { FRESH(); final_phase(kargs(), gw, NGW, lane); }
#undef IN
#undef SEAM
}

extern "C" void kernel_launch(void* const* d_in, const int* in_sizes, int n_in, void* d_out, int out_size, void* d_ws, size_t ws_size, hipStream_t stream) {
    static int grid = 0;
    if (grid == 0) {
        if (n_in != 25 || (size_t)out_size != O_END || ws_size < WS_END) { fprintf(stderr, "kernel_launch: unexpected shapes (n_in %d out %d ws %zu); nothing launched\n", n_in, out_size, ws_size); grid = -1; return; }
        int dev = 0, cus = 0, per_cu = 0;
        if (hipGetDevice(&dev) != hipSuccess || hipDeviceGetAttribute(&cus, hipDeviceAttributeMultiprocessorCount, dev) != hipSuccess) { grid = -1; return; }
        if (hipFuncSetAttribute((const void*)fwd, hipFuncAttributeMaxDynamicSharedMemorySize, LDS_BYTES) != hipSuccess) { fprintf(stderr, "kernel_launch: hipFuncSetAttribute failed\n"); grid = -1; return; }
        if (hipOccupancyMaxActiveBlocksPerMultiprocessor(&per_cu, (const void*)fwd, NTHR, LDS_BYTES) != hipSuccess || per_cu < 1) fprintf(stderr, "kernel_launch: occupancy query says %d\n", per_cu);
        (void)hipGetLastError();
        grid = cus;
    }
    if (grid < 0) return;
    (void)hipMemsetAsync((char*)d_ws + WS_CTL, 0, CTL_ZERO_BYTES, stream);
    Args a{};
    for (int i = 0; i < 25; ++i) a.in[i] = (const float*)d_in[i];
    a.out = (float*)d_out; a.ws = (unsigned char*)d_ws;
#if MK_ONE_LAUNCH
    a.ph_lo = 0; a.ph_hi = NPHASE;
    hipLaunchKernelGGL(fwd, dim3(grid), dim3(NTHR), LDS_BYTES, stream, a);
#else
    for (int ph = 0; ph < NPHASE; ++ph) { a.ph_lo = ph; a.ph_hi = ph + 1; hipLaunchKernelGGL(fwd, dim3(grid), dim3(NTHR), LDS_BYTES, stream, a); }
#endif
}
```
